# Optimizing an MI355X kernel written in HIP

```python
import jax, jax.numpy as jnp
from jax import lax
import numpy as np

D_MODEL = 1024
BATCH = 8
SEQ = 4096
DEPTH = 4

GRID_W = 64
CTX_LEN = 256
HG_HEADS = 4
HG_DK = 128
HG_DV = 128
HG_KW = HG_HEADS * HG_DK
HG_W = HG_HEADS * HG_DV
HG_CHUNK = 64
NA_HEADS = 8
NA_HD = 64
NA_W = NA_HEADS * NA_HD
NA_WIN_R = 8
NA_WIN_C = 16
ROPE_THETA = 10000.0
SC_W = 512
SC_K = 3
D_FF = 4 * D_MODEL
N_MOD = 6
EPS = 1e-6
SPLIT_SIZES = (HG_KW, HG_KW, HG_KW, HG_W, HG_W, NA_W, NA_W, NA_W, SC_W, SC_W, SC_W, D_MODEL, D_MODEL, D_MODEL)
PROJ_W = sum(SPLIT_SIZES)
SPLIT_POINTS = tuple(sum(SPLIT_SIZES[:i + 1]) for i in range(len(SPLIT_SIZES) - 1))

kernel_name = "hybrid_hgrn2_natten_shortconv_dit_block"


def _rms_norm(x, w):
    xf = x.astype(jnp.float32)
    y = xf * lax.rsqrt(jnp.mean(jnp.square(xf), axis=-1, keepdims=True) + EPS)
    return (y * w.astype(jnp.float32)).astype(x.dtype)


def _modulate(x, w, shift, scale):
    return _rms_norm(x, w) * (1.0 + scale) + shift


def _axial_rope_tables(n_tokens):
    t = jnp.arange(n_tokens)
    pos = jnp.stack([t // GRID_W, t % GRID_W], axis=-1).astype(jnp.float32)
    half = NA_HD // 2
    inv = ROPE_THETA ** (-jnp.arange(0, half, 2, dtype=jnp.float32) / half)
    ang = pos[:, :, None] * inv
    return jnp.cos(ang), jnp.sin(ang)


def _apply_axial_rope(x, cos, sin):
    B_, S_, H, d = x.shape
    xa = x.astype(jnp.float32).reshape(B_, S_, H, 2, 2, d // 4)
    x1, x2 = xa[..., 0, :], xa[..., 1, :]
    cs, sn = cos[:, None], sin[:, None]
    out = jnp.stack([x1 * cs - x2 * sn, x2 * cs + x1 * sn], axis=-2)
    return out.reshape(B_, S_, H, d).astype(x.dtype)


def _gla_chunk_scan(q, k, v, log_f, s0):
    B_, L, H, _ = q.shape
    n = L // HG_CHUNK

    def to_chunks(a):
        return a.reshape(B_, n, HG_CHUNK, H, a.shape[-1]).transpose(1, 0, 3, 2, 4)

    qc, kc, vc, gc = (to_chunks(a) for a in (q, k, v, log_f))
    incl = jnp.tril(jnp.ones((HG_CHUNK, HG_CHUNK), dtype=bool))

    def step(s, inp):
        qi, ki, vi, gi = inp
        G = jnp.cumsum(gi, axis=2)
        inter = jnp.einsum('bhtk,bhkv->bhtv', qi * jnp.exp(G), s)
        diff = G[:, :, :, None, :] - G[:, :, None, :, :]
        decay = jnp.exp(jnp.where(incl[:, :, None], diff, -jnp.inf))
        attn = jnp.einsum('bhtk,bhtsk,bhsk->bhts', qi, decay, ki)
        intra = jnp.einsum('bhts,bhsv->bhtv', attn, vi)
        G_last = G[:, :, -1:, :]
        s_new = jnp.exp(G_last[:, :, 0, :])[..., None] * s + jnp.einsum(
            'bhsk,bhsv->bhkv', ki * jnp.exp(G_last - G), vi)
        return s_new, inter + intra

    s_fin, out = lax.scan(step, s0, (qc, kc, vc, gc))
    out = out.transpose(1, 0, 3, 2, 4).reshape(B_, L, H, v.shape[-1])
    return out, s_fin


def _hgrn2_direction(q_raw, f_raw, i_raw, lb, s0, reverse):
    B_, L, _ = q_raw.shape

    def heads(a):
        return a.astype(jnp.float32).reshape(B_, L, HG_HEADS, -1)

    q = heads(jax.nn.silu(q_raw.astype(jnp.float32)))
    g = lb + (1.0 - lb) * jax.nn.sigmoid(f_raw.astype(jnp.float32))
    k = heads(1.0 - g)
    log_f = heads(jnp.log(g))
    v = heads(i_raw)
    if reverse:
        q, k, v, log_f = (jnp.flip(a, axis=1) for a in (q, k, v, log_f))
    o, s = _gla_chunk_scan(q, k, v, log_f, s0)
    if reverse:
        o = jnp.flip(o, axis=1)
    return o, s


def _hgrn2_readout(o, g_raw, w):
    B_, L, _ = g_raw.shape
    y = _rms_norm(o, w).reshape(B_, L, HG_W) * jax.nn.silu(g_raw.astype(jnp.float32))
    return y.astype(g_raw.dtype)


def _hgrn2_mixer(z_lat, z_ctx, lb_f, lb_b, onorm_w, need_ctx):
    q_l, ff_l, fb_l, i_l, g_l = z_lat
    q_c, ff_c, fb_c, i_c, g_c = z_ctx
    s0 = jnp.zeros((q_l.shape[0], HG_HEADS, HG_DK, HG_DV), jnp.float32)
    oc_f, s_f = _hgrn2_direction(q_c, ff_c, i_c, lb_f, s0, False)
    ol_f, _ = _hgrn2_direction(q_l, ff_l, i_l, lb_f, s_f, False)
    oc_b, s_b = _hgrn2_direction(q_c, fb_c, i_c, lb_b, s0, True)
    ol_b, _ = _hgrn2_direction(q_l, fb_l, i_l, lb_b, s_b, True)
    y_lat = _hgrn2_readout(ol_f + ol_b, g_l, onorm_w)
    y_ctx = _hgrn2_readout(oc_f + oc_b, g_c, onorm_w) if need_ctx else None
    return y_lat, y_ctx


def _natten_mixer(z_lat, z_ctx, qn_w, kn_w, rpb, rope, need_ctx):
    q_l, k_l, v_l = z_lat
    q_c, k_c, v_c = z_ctx
    B_, S_, _ = q_l.shape
    rows = S_ // GRID_W
    wr = min(NA_WIN_R, rows)
    scale = NA_HD ** -0.5
    cos, sin = rope

    def heads(a):
        return a.reshape(a.shape[0], a.shape[1], NA_HEADS, NA_HD)

    ql = _apply_axial_rope(_rms_norm(heads(q_l), qn_w), cos, sin)
    kl = _apply_axial_rope(_rms_norm(heads(k_l), kn_w), cos, sin)
    vl = heads(v_l)
    kc_h = _rms_norm(heads(k_c), kn_w).transpose(0, 2, 1, 3)
    vc_h = heads(v_c).transpose(0, 2, 1, 3)

    q_rows = ql.reshape(B_, rows, GRID_W, NA_HEADS, NA_HD).transpose(1, 0, 3, 2, 4)
    k_grid = kl.reshape(B_, rows, GRID_W, NA_HEADS, NA_HD).transpose(0, 3, 1, 2, 4)
    v_grid = vl.reshape(B_, rows, GRID_W, NA_HEADS, NA_HD).transpose(0, 3, 1, 2, 4)

    cols = np.arange(GRID_W)
    col_start = np.clip(cols - NA_WIN_C // 2, 0, GRID_W - NA_WIN_C)
    col_idx = col_start[:, None] + np.arange(NA_WIN_C)
    col_bias_ix = col_idx - cols[:, None] + (NA_WIN_C - 1)
    n_loc = wr * NA_WIN_C

    def row_attn(args):
        r, q_r = args
        r0 = jnp.clip(r - wr // 2, 0, rows - wr)
        k_band = lax.dynamic_slice_in_dim(k_grid, r0, wr, axis=2)
        v_band = lax.dynamic_slice_in_dim(v_grid, r0, wr, axis=2)
        k_win = k_band[:, :, :, col_idx]
        v_win = v_band[:, :, :, col_idx]
        s_loc = jnp.einsum('bhqd,bhrqcd->bhqrc', q_r, k_win) * scale
        row_bias_ix = r0 + jnp.arange(wr) - r + (NA_WIN_R - 1)
        bias = rpb[:, row_bias_ix[None, :, None], col_bias_ix[:, None, :]]
        s_loc = s_loc + bias[None]
        s_ctx = jnp.einsum('bhqd,bhkd->bhqk', q_r, kc_h) * scale
        logits = jnp.concatenate([s_loc.reshape(B_, NA_HEADS, GRID_W, n_loc), s_ctx], axis=-1)
        p = jax.nn.softmax(logits.astype(jnp.float32), axis=-1).astype(v_win.dtype)
        p_loc = p[..., :n_loc].reshape(B_, NA_HEADS, GRID_W, wr, NA_WIN_C)
        p_ctx = p[..., n_loc:]
        return (jnp.einsum('bhqrc,bhrqcd->bhqd', p_loc, v_win)
                + jnp.einsum('bhqk,bhkd->bhqd', p_ctx, vc_h))

    o = lax.map(row_attn, (jnp.arange(rows), q_rows))
    y_lat = o.transpose(1, 0, 3, 2, 4).reshape(B_, S_, NA_W)

    y_ctx = None
    if need_ctx:
        qc_h = _rms_norm(heads(q_c), qn_w).transpose(0, 2, 1, 3)
        sc = jnp.einsum('bhqd,bhkd->bhqk', qc_h, kc_h) * scale
        pc = jax.nn.softmax(sc.astype(jnp.float32), axis=-1).astype(vc_h.dtype)
        oc = jnp.einsum('bhqk,bhkd->bhqd', pc, vc_h)
        y_ctx = oc.transpose(0, 2, 1, 3).reshape(q_c.shape[0], q_c.shape[1], NA_W)
    return y_lat, y_ctx


def _short_conv(b_gate, c_gate, x_in, w):
    u = c_gate * x_in
    up = jnp.pad(u, ((0, 0), (1, 1), (0, 0)))
    y = up[:, :-2] * w[0] + up[:, 1:-1] * w[1] + up[:, 2:] * w[2]
    return b_gate * y


def _branch_merge(ya, yb, yc, gates, wa, wb, wc, wo):
    ga, gb, gc = (jax.nn.sigmoid(g) for g in gates)
    mix = ga * (ya @ wa) + gb * (yb @ wb) + gc * (yc @ wc)
    return mix @ wo


def _sq_relu_mlp(h, w1, w2):
    return jnp.square(jax.nn.relu(h @ w1)) @ w2


def setup_inputs(seed: int = 0) -> dict:
    key = jax.random.key(seed)
    ks = jax.random.split(key, 24)

    def nrm(k, shape, scale):
        return jax.random.normal(k, shape, jnp.float32) * scale

    D = D_MODEL
    return {
        "x": nrm(ks[0], (BATCH, SEQ, D), 1.0),
        "c": nrm(ks[1], (BATCH, D), 1.0),
        "ctx": nrm(ks[2], (BATCH, CTX_LEN, D), 1.0),
        "c_ctx": nrm(ks[3], (D,), 1.0),
        "ada_w": nrm(ks[4], (DEPTH, D, N_MOD * D), 0.25 * D ** -0.5),
        "ada_b": nrm(ks[5], (DEPTH, N_MOD * D), 0.02),
        "norm1_w": 1.0 + nrm(ks[6], (DEPTH, D), 0.02),
        "norm2_w": 1.0 + nrm(ks[7], (DEPTH, D), 0.02),
        "w_in": nrm(ks[8], (DEPTH, D, PROJ_W), D ** -0.5),
        "hgrn_lb_logits": nrm(ks[9], (2, DEPTH, HG_KW), 0.5),
        "hgrn_onorm_w": 1.0 + nrm(ks[10], (DEPTH, HG_DV), 0.02),
        "q_norm_w": 1.0 + nrm(ks[11], (DEPTH, NA_HD), 0.02),
        "k_norm_w": 1.0 + nrm(ks[12], (DEPTH, NA_HD), 0.02),
        "natten_rpb": nrm(ks[13], (DEPTH, NA_HEADS, 2 * NA_WIN_R - 1, 2 * NA_WIN_C - 1), 0.1),
        "conv_w": nrm(ks[14], (DEPTH, SC_K, SC_W), SC_K ** -0.5),
        "w_branch_a": nrm(ks[15], (DEPTH, HG_W, D), HG_W ** -0.5),
        "w_branch_b": nrm(ks[16], (DEPTH, NA_W, D), NA_W ** -0.5),
        "w_branch_c": nrm(ks[17], (DEPTH, SC_W, D), SC_W ** -0.5),
        "w_out": nrm(ks[18], (DEPTH, D, D), D ** -0.5),
        "mlp_w1": nrm(ks[19], (DEPTH, D, D_FF), D ** -0.5),
        "mlp_w2": nrm(ks[20], (DEPTH, D_FF, D), D_FF ** -0.5),
    }


def reference(x, c, ctx, c_ctx, ada_w, ada_b, norm1_w, norm2_w, w_in, hgrn_lb_logits,
              hgrn_onorm_w, q_norm_w, k_norm_w, natten_rpb, conv_w, w_branch_a, w_branch_b,
              w_branch_c, w_out, mlp_w1, mlp_w2):
    S_ = x.shape[1]
    rope = _axial_rope_tables(S_)
    lb_p = jax.nn.softmax(hgrn_lb_logits.astype(jnp.float32), axis=1)
    lower_bounds = jnp.cumsum(lb_p, axis=1) - lb_p[:, :1]
    silu_c = jax.nn.silu(c)
    silu_cc = jax.nn.silu(c_ctx)
    h_ctx = ctx
    for l in range(DEPTH):
        need_ctx = l < DEPTH - 1
        mod_lat = jnp.split((silu_c @ ada_w[l] + ada_b[l])[:, None, :], N_MOD, axis=-1)
        mod_ctx = jnp.split(silu_cc @ ada_w[l] + ada_b[l], N_MOD, axis=-1)
        z_lat = jnp.split(_modulate(x, norm1_w[l], mod_lat[0], mod_lat[1]) @ w_in[l], SPLIT_POINTS, axis=-1)
        z_ctx = jnp.split(_modulate(h_ctx, norm1_w[l], mod_ctx[0], mod_ctx[1]) @ w_in[l], SPLIT_POINTS, axis=-1)

        ya_lat, ya_ctx = _hgrn2_mixer(z_lat[0:5], z_ctx[0:5], lower_bounds[0, l], lower_bounds[1, l],
                                      hgrn_onorm_w[l], need_ctx)
        yb_lat, yb_ctx = _natten_mixer(z_lat[5:8], z_ctx[5:8], q_norm_w[l], k_norm_w[l],
                                       natten_rpb[l], rope, need_ctx)
        yc_lat = _short_conv(z_lat[8], z_lat[9], z_lat[10], conv_w[l])

        x = x + mod_lat[2] * _branch_merge(ya_lat, yb_lat, yc_lat, z_lat[11:14], w_branch_a[l],
                                           w_branch_b[l], w_branch_c[l], w_out[l])
        x = x + mod_lat[5] * _sq_relu_mlp(_modulate(x, norm2_w[l], mod_lat[3], mod_lat[4]),
                                          mlp_w1[l], mlp_w2[l])
        if need_ctx:
            yc_ctx = _short_conv(z_ctx[8], z_ctx[9], z_ctx[10], conv_w[l])
            h_ctx = h_ctx + mod_ctx[2] * _branch_merge(ya_ctx, yb_ctx, yc_ctx, z_ctx[11:14], w_branch_a[l],
                                                       w_branch_b[l], w_branch_c[l], w_out[l])
            h_ctx = h_ctx + mod_ctx[5] * _sq_relu_mlp(_modulate(h_ctx, norm2_w[l], mod_ctx[3], mod_ctx[4]),
                                                      mlp_w1[l], mlp_w2[l])
    return x
```

```cpp
#include <hip/hip_runtime.h>
#include <hip/hip_cooperative_groups.h>
#include <cstdio>
#include <cstdint>
namespace cg = cooperative_groups;

typedef unsigned short bf16_t;
typedef short bf16x8 __attribute__((ext_vector_type(8)));
typedef float f32x4 __attribute__((ext_vector_type(4)));
typedef unsigned u32x2 __attribute__((ext_vector_type(2)));
typedef unsigned u32x4 __attribute__((ext_vector_type(4)));

constexpr int D = 1024, NB = 8, SEQ = 4096, DEPTH = 4, CTX = 256, PROJ = 8704, DFF = 4096, NMOD = 6;
constexpr int ZLD = 5632;
constexpr int NBLK = 256;
constexpr int GB = 4, NG = NB / GB;
constexpr int MLAT = GB * SEQ, MCTX = NB * CTX, MG = MLAT + MCTX;
constexpr int ZQ = 0, ZFF = 512, ZFB = 1024, ZI = 1536, ZG = 2048, ZNQ = 2560, ZNK = 3072, ZNV = 3584, ZCB = 4096, ZCC = 4608, ZCX = 5120, ZGA = 5632, ZGB = 6656, ZGC = 7680;
constexpr int LDS_BYTES = 140 * 1024, LDS_TOP = LDS_BYTES;
constexpr size_t XCD_BAR_BYTES = 3456 * 4 + 1024;
constexpr int NSC = 16;

constexpr size_t SZ_WIN = (size_t)PROJ * D * 2, SZ_WBR = (size_t)D * 512 * 2, SZ_WO = (size_t)D * D * 2, SZ_W1 = (size_t)DFF * D * 2, SZ_W2 = (size_t)D * DFF * 2;
constexpr size_t OFF_WIN = 0, OFF_WA = OFF_WIN + SZ_WIN, OFF_WB = OFF_WA + SZ_WBR, OFF_WC = OFF_WB + SZ_WBR, OFF_WO = OFF_WC + SZ_WBR, OFF_W1 = OFF_WO + SZ_WO, OFF_W2 = OFF_W1 + SZ_W1;
constexpr size_t OFF_MOD = OFF_W2 + SZ_W2;
constexpr size_t OFF_ROPE = OFF_MOD + (size_t)DEPTH * 9 * NMOD * D * 4;
constexpr size_t OFF_LB = OFF_ROPE + 64 * 16 * 8;
constexpr size_t OFF_HCTX = OFF_LB + 2 * DEPTH * 512 * 4;
constexpr size_t OFF_HN = OFF_HCTX + (size_t)NB * CTX * D * 4;
constexpr size_t OFF_Z = OFF_HN + (size_t)MG * D * 2;
constexpr size_t OFF_GATE = OFF_Z + (size_t)MG * ZLD * 2;
constexpr size_t OFF_Y = OFF_GATE + (size_t)3 * (MG / 256) * 4 * 32 * 512 * 8;
constexpr size_t OFF_MIX = OFF_Y + 3 * (size_t)MG * 512 * 2;
constexpr size_t OFF_VT = OFF_MIX + (size_t)MG * D * 2;
constexpr size_t OFF_VTC = OFF_VT + (size_t)GB * 8 * 64 * SEQ * 2;
constexpr size_t OFF_HD = OFF_VTC + (size_t)NB * 8 * 64 * CTX * 2;
constexpr size_t OFF_LCTX = OFF_HD + (size_t)GB * 4 * 2 * NSC * 128 * 4;
constexpr size_t OFF_HDC = OFF_LCTX + (size_t)NB * 4 * 2 * 16384 * 4;
constexpr size_t OFF_UC = OFF_HDC + (size_t)NB * 4 * 2 * 128 * 4;
constexpr size_t OFF_SLAB = OFF_UC + (size_t)MCTX * DFF * 2;
constexpr size_t OFF_BAR = OFF_SLAB + (size_t)2 * MCTX * D * 4;
constexpr size_t WS_NEED = OFF_BAR + XCD_BAR_BYTES;

struct Params {
  const float *x, *c, *ctx, *c_ctx, *ada_w, *ada_b, *norm1_w, *norm2_w, *w_in, *lb_logits, *onorm_w, *qn_w, *kn_w, *rpb, *conv_w, *w_a, *w_b, *w_c, *w_out, *w1, *w2;
  float* out; char* ws; int ph_lo, ph_hi;
};

typedef float f32x2_ __attribute__((ext_vector_type(2)));
typedef __bf16 bf16x2_ __attribute__((ext_vector_type(2)));
__device__ __forceinline__ unsigned cvt_pk_bf16(float lo, float hi) { const f32x2_ v = {lo, hi}; const bf16x2_ b = __builtin_convertvector(v, bf16x2_); return __builtin_bit_cast(unsigned, b); }
__device__ __forceinline__ bf16_t f2bf(float f) { return (bf16_t)(cvt_pk_bf16(f, 0.f) & 0xffffu); }
__device__ __forceinline__ float bf2f(bf16_t h) { return __uint_as_float(((unsigned)h) << 16); }
__device__ __forceinline__ float bflo(unsigned u) { return __uint_as_float(u << 16); }
__device__ __forceinline__ float bfhi(unsigned u) { return __uint_as_float(u & 0xffff0000u); }
__device__ __forceinline__ float sigmoidf_(float v) { return __builtin_amdgcn_rcpf(1.f + __builtin_amdgcn_exp2f(-1.4426950408889634f * v)); }
__device__ __forceinline__ float siluf_(float v) { return v * __builtin_amdgcn_rcpf(1.f + __builtin_amdgcn_exp2f(-1.4426950408889634f * v)); }

#define LAS __attribute__((address_space(3)))
constexpr int BM = 256, BK = 64, HALF = 128, HTB = HALF * BK * 2, GEMM_LDS = 8 * HTB;
__device__ __forceinline__ int lds_byte(int r, int c) { const int st = (r >> 4) * 2 + (c >> 5), rr = r & 15, cc = c & 31, ob = rr * 64 + cc * 2; return st * 1024 + (ob ^ (((ob >> 9) & 1) << 5)); }
__device__ __forceinline__ void stage_rc(int b, int& R, int& C) { const int st = b / 1024, sb = b % 1024, swz = sb ^ (((sb >> 9) & 1) << 5); R = (st >> 1) * 16 + swz / 64; C = (st & 1) * 32 + (swz % 64) / 2; }

__device__ __forceinline__ int bid_() { int b = blockIdx.x; asm volatile("" : "+s"(b)); return b; }
struct Unit { int pm, pn, br; };
__device__ __forceinline__ void tile_map(int L, int nM, int nN, int& pm, int& pn) {
  const int nwg = nM * nN; int wgid = L;
  { const int q = nwg / 8, r = nwg % 8, xcd = wgid % 8, off = wgid / 8; wgid = (xcd < r ? xcd * (q + 1) : r * (q + 1) + (xcd - r) * q) + off; }
  constexpr int WGM = 4; const int nig = WGM * nN, gid = wgid / nig, fm = gid * WGM, gsz = (nM - fm) < WGM ? (nM - fm) : WGM;
  pm = fm + ((wgid % nig) % gsz); pn = (wgid % nig) / gsz;
}
template <int NBR> struct Sched {
  int nM, nN, pm0, boff;
  __device__ __forceinline__ bool next(int i, Unit& u) const {
    const int c = (bid_() + (int)gridDim.x - boff) % (int)gridDim.x;
    const int L = (i / NBR) * (int)gridDim.x + c; if (L >= nM * nN) return false;
    tile_map(L, nM, nN, u.pm, u.pn); u.pm += pm0; u.br = i % NBR; return true;
  }
};
struct SchedOne { int pm, pn; __device__ __forceinline__ bool next(int i, Unit& u) const { if (i) return false; u.pm = pm; u.pn = pn; u.br = 0; return true; } };
struct SchedSplit2 {
  __device__ __forceinline__ bool next(int i, Unit& u) const {
    const int L = i * (int)gridDim.x + bid_(); if (L >= 64) return false;
    const int t = L >> 1; u.pm = MLAT / 256 + (t >> 2); u.pn = t & 3; u.br = L & 1; return true;
  }
};

__device__ __forceinline__ int perm32(int rho) { const int n = rho >> 4, i = rho & 15; return 8 * (i >> 2) + 4 * n + (i & 3); }
template <bool PERM, class S, class FA, class FB, class Epi>
__device__ __forceinline__ void gemm_phase(LAS unsigned char* lds, const int K, const int ld, const S& Sc, const FA& baseA, const FB& baseB, const Epi& E) {
  int tid = threadIdx.x; asm volatile("" : "+v"(tid));
  const int wid = __builtin_amdgcn_readfirstlane(tid >> 6), lane = tid & 63, wr = wid >> 2, wc = wid & 3, fr = lane & 15, fq = lane >> 4;
  const int nt = K / BK;
  unsigned voff[2], voffb[2];
#pragma unroll
  for (int i = 0; i < 2; ++i) { int R, C; stage_rc(tid * 16 + i * 8192, R, C); voff[i] = (unsigned)(R * ld + C) * 2u; const int Rb = PERM ? ((R & ~31) + perm32(R & 31)) : R; voffb[i] = (unsigned)(Rb * ld + C) * 2u; }
  const size_t kstep = (size_t)(BK * 2), hstep = (size_t)HALF * ld * 2, tstep = 2 * hstep;
  const unsigned ldsw = (unsigned)wid * 1024u;
  const int aoff = lds_byte(wr * 64 + fr, fq * 8), boff = lds_byte(wc * 32 + fr, fq * 8);
#define G_SA(b, h) (((b) * 2 + (h)) * HTB)
#define G_SB(b, h) ((4 + (b) * 2 + (h)) * HTB)
#define G_STAGEB(bufoff, gbase) do { _Pragma("unroll") for (int _i = 0; _i < 2; ++_i) \
    __builtin_amdgcn_global_load_lds((const unsigned*)((const char*)(gbase) + voffb[_i]), (LAS unsigned*)(lds + (bufoff) + ldsw + _i * 8192), 16, 0, 0); } while (0)
#define G_STAGE(bufoff, gbase) do { _Pragma("unroll") for (int _i = 0; _i < 2; ++_i) \
    __builtin_amdgcn_global_load_lds((const unsigned*)((const char*)(gbase) + voff[_i]), (LAS unsigned*)(lds + (bufoff) + ldsw + _i * 8192), 16, 0, 0); } while (0)
#define G_LDA(dst, b, h) do { _Pragma("unroll") for (int m = 0; m < 4; ++m) _Pragma("unroll") for (int k = 0; k < 2; ++k) dst[m][k] = *(const LAS bf16x8*)(lds + G_SA(b, h) + aoff + m * 2048 + k * 1024); } while (0)
#define G_LDB(dst, b, h) do { _Pragma("unroll") for (int n = 0; n < 2; ++n) _Pragma("unroll") for (int k = 0; k < 2; ++k) dst[n][k] = *(const LAS bf16x8*)(lds + G_SB(b, h) + boff + n * 2048 + k * 1024); } while (0)
#define G_MMA(ai, bj, At_, Bt_) do { __builtin_amdgcn_s_setprio(1); _Pragma("unroll") for (int m = 0; m < 4; ++m) _Pragma("unroll") for (int n = 0; n < 2; ++n) _Pragma("unroll") for (int k = 0; k < 2; ++k) \
    acc[ai][bj][m][n] = __builtin_amdgcn_mfma_f32_16x16x32_bf16(Bt_[n][k], At_[m][k], acc[ai][bj][m][n], 0, 0, 0); __builtin_amdgcn_s_setprio(0); } while (0)
#define WAIT_V(n) asm volatile("s_waitcnt vmcnt(" #n ")" ::: "memory")
#define WAIT_L(n) asm volatile("s_waitcnt lgkmcnt(" #n ")" ::: "memory")
#define BAR __builtin_amdgcn_s_barrier()
#define SCHED __builtin_amdgcn_sched_barrier(0)
  Unit cur, nxt; int ui = 0;
  if (!Sc.next(0, cur)) return;
  f32x4 acc[2][2][4][2];
#pragma unroll
  for (int a = 0; a < 2; ++a)
#pragma unroll
    for (int b = 0; b < 2; ++b)
#pragma unroll
      for (int m = 0; m < 4; ++m)
#pragma unroll
        for (int n = 0; n < 2; ++n) acc[a][b][m][n] = (f32x4){0.f, 0.f, 0.f, 0.f};
  bf16x8 At[4][2], B0[2][2], B1[2][2];
  const char* cA = baseA(cur) + (size_t)cur.pm * tstep; const char* cB = baseB(cur) + (size_t)cur.pn * tstep;
  G_STAGEB(G_SB(0, 0), cB); G_STAGE(G_SA(0, 0), cA); G_STAGEB(G_SB(0, 1), cB + hstep); G_STAGE(G_SA(0, 1), cA + hstep);
  if (wr == 1) BAR;
  WAIT_V(4); BAR;
  G_STAGEB(G_SB(1, 0), cB + kstep); G_STAGE(G_SA(1, 0), cA + kstep); G_STAGEB(G_SB(1, 1), cB + hstep + kstep);
  WAIT_V(6); BAR;
  for (;;) {
    const bool has_next = Sc.next(ui + 1, nxt);
    const char* nA = has_next ? baseA(nxt) + (size_t)nxt.pm * tstep : cA; const char* nB = has_next ? baseB(nxt) + (size_t)nxt.pn * tstep : cB;
    for (int t = 0; t < nt; t += 2) {
      const bool last = (t == nt - 2);
      const char* a1 = cA + (size_t)(t + 1) * kstep;
      const char* a2 = last ? nA : cA + (size_t)(t + 2) * kstep; const char* b2 = last ? nB : cB + (size_t)(t + 2) * kstep;
      const char* a3 = a2 + kstep; const char* b3 = b2 + kstep;
      G_LDB(B0, 0, 0); SCHED; G_LDA(At, 0, 0); G_STAGE(G_SA(1, 1), a1 + hstep);
      WAIT_L(8); BAR; WAIT_L(0); G_MMA(0, 0, At, B0); BAR; SCHED;
      G_LDB(B1, 0, 1); G_STAGEB(G_SB(0, 0), b2);
      BAR; WAIT_L(0); G_MMA(0, 1, At, B1); BAR;
      G_LDA(At, 0, 1); G_STAGE(G_SA(0, 0), a2);
      BAR; WAIT_L(0); G_MMA(1, 0, At, B0); BAR; SCHED;
      G_STAGEB(G_SB(0, 1), b2 + hstep);
      WAIT_V(6); BAR; G_MMA(1, 1, At, B1); BAR;
      G_LDB(B0, 1, 0); SCHED; G_LDA(At, 1, 0); G_STAGE(G_SA(0, 1), a2 + hstep);
      WAIT_L(8); BAR; WAIT_L(0); G_MMA(0, 0, At, B0); BAR; SCHED;
      G_LDB(B1, 1, 1); G_STAGEB(G_SB(1, 0), b3);
      BAR; WAIT_L(0); G_MMA(0, 1, At, B1); BAR;
      G_LDA(At, 1, 1); G_STAGE(G_SA(1, 0), a3);
      BAR; WAIT_L(0); G_MMA(1, 0, At, B0); BAR; SCHED;
      G_STAGEB(G_SB(1, 1), b3 + hstep);
      WAIT_V(6); BAR; G_MMA(1, 1, At, B1); BAR;
    }
    E(acc, cur, wr, wc, fr, fq);
    if (!has_next) break;
#pragma unroll
    for (int a = 0; a < 2; ++a)
#pragma unroll
      for (int b = 0; b < 2; ++b)
#pragma unroll
        for (int m = 0; m < 4; ++m)
#pragma unroll
          for (int n = 0; n < 2; ++n) acc[a][b][m][n] = (f32x4){0.f, 0.f, 0.f, 0.f};
    cur = nxt; cA = nA; cB = nB; ++ui;
  }
  WAIT_V(0);
  if (wr == 0) BAR;
  BAR;
}

#define EPI_LOOP(...) \
  _Pragma("unroll") for (int ai = 0; ai < 2; ++ai) _Pragma("unroll") for (int m = 0; m < 4; ++m) { const int row = u.pm * BM + ai * HALF + wr * 64 + m * 16 + fr; \
    _Pragma("unroll") for (int bj = 0; bj < 2; ++bj) _Pragma("unroll") for (int n = 0; n < 2; ++n) { const int col = u.pn * BM + bj * HALF + wc * 32 + n * 16 + fq * 4; f32x4 v = acc[ai][bj][m][n]; __VA_ARGS__ } }
#define EPI_SIG (const f32x4 (&acc)[2][2][4][2], const Unit& u, int wr, int wc, int fr, int fq)

__device__ __forceinline__ float* resid_row(const Params& p, int g, int row, int& modr) {
  if (row < MLAT) { const int b = g * GB + (row >> 12); modr = b; return p.out + ((size_t)b * SEQ + (row & 4095)) * D; }
  const int r = row - MLAT; modr = 8; return (float*)(p.ws + OFF_HCTX) + (size_t)r * D;
}


#define XB_TMO      128
#define XB_XCNT(j)  (256  + 64 * (j))
#define XB_XSUB(j)  (1280 + 64 * (j))
#define XB_XGEN(j)  (2304 + 64 * (j))
#define XB_TOP      3328
#define XB_TOPGEN   3392
#define XCD_BAR_WORDS 3456
#define XB_SPIN_CAP (1u << 20)
__device__ __forceinline__ unsigned xb_ld(unsigned* p)              { return __hip_atomic_load(p, __ATOMIC_RELAXED, __HIP_MEMORY_SCOPE_AGENT); }
__device__ __forceinline__ unsigned xb_add(unsigned* p, unsigned v) { return __hip_atomic_fetch_add(p, v, __ATOMIC_RELAXED, __HIP_MEMORY_SCOPE_AGENT); }
__device__ __forceinline__ unsigned xb_xcc_id() { return (unsigned)__builtin_amdgcn_s_getreg((3 << 11) | 20) & 0xFu; }
#define XB_SPIN(cond, bar) do { unsigned _sp = 0; while (cond) { __builtin_amdgcn_s_sleep(1); \
    if ((++_sp & 255u) == 0u) { if (xb_ld(&(bar)[XB_TMO])) break; if (_sp > XB_SPIN_CAP) { atomicAdd(&(bar)[XB_TMO], 1u); break; } } } } while (0)
struct XcdBarrier { unsigned* bar; unsigned x; volatile LAS unsigned* st; };
__device__ __forceinline__ XcdBarrier xcd_barrier_post(unsigned* bar, volatile LAS unsigned* st) {
  XcdBarrier b; b.bar = bar; b.x = xb_xcc_id(); b.st = st;
  if (threadIdx.x == 0) (void)xb_add(&bar[XB_XCNT(b.x)], 1u);
  return b;
}
__device__ __forceinline__ void xcd_barrier_complete(unsigned* bar, unsigned x, unsigned& nloc, unsigned& nx) {
  const unsigned G = gridDim.x * gridDim.y * gridDim.z;
  unsigned sum, cnt, mine, sp = 0u;
  for (;;) {
    sum = 0u; cnt = 0u; mine = 0u;
#pragma unroll
    for (unsigned j = 0; j < 16; ++j) { const unsigned c = xb_ld(&bar[XB_XCNT(j)]); sum += c; cnt += (c > 0u) ? 1u : 0u; mine = (j == x) ? c : mine; }
    if (sum == G) break;
    __builtin_amdgcn_s_sleep(1);
    if ((++sp & 255u) == 0u) { if (xb_ld(&bar[XB_TMO])) break; if (sp > XB_SPIN_CAP) { atomicAdd(&bar[XB_TMO], 1u); break; } }
  }
  nloc = mine > 0u ? mine : 1u; nx = cnt > 0u ? cnt : 1u;
}
__device__ __forceinline__ void xcd_barrier(const XcdBarrier& b) {
  asm volatile("s_waitcnt vmcnt(0)" ::: "memory");
  __syncthreads();
  if (threadIdx.x == 0) {
    unsigned* bar = b.bar;
    __builtin_amdgcn_s_waitcnt(0);
    unsigned nloc = b.st[0], nx = b.st[1];
    if (nloc == 0u) { xcd_barrier_complete(bar, b.x, nloc, nx); b.st[0] = nloc; b.st[1] = nx; }
    const unsigned old = xb_add(&bar[XB_XSUB(b.x)], 1u);
    const unsigned gen = old / nloc;
    if (old + 1u == (gen + 1u) * nloc) {
      __builtin_amdgcn_fence(__ATOMIC_RELEASE, "agent");
      asm volatile("s_waitcnt vmcnt(0)" ::: "memory");
      const unsigned og = xb_add(&bar[XB_TOP], 1u);
      const unsigned tg = og / nx;
      if (og + 1u == (tg + 1u) * nx) xb_add(&bar[XB_TOPGEN], 1u);
      else XB_SPIN(xb_ld(&bar[XB_TOPGEN]) == tg, bar);
      __builtin_amdgcn_fence(__ATOMIC_ACQUIRE, "agent");
      xb_add(&bar[XB_XGEN(b.x)], 1u);
      asm volatile("s_waitcnt vmcnt(0)" ::: "memory");
    } else {
      XB_SPIN(xb_ld(&bar[XB_XGEN(b.x)]) == gen, bar);
      __builtin_amdgcn_fence(__ATOMIC_ACQUIRE, "agent");
      asm volatile("s_waitcnt vmcnt(0)" ::: "memory");
    }
  }
  __syncthreads();
}

__device__ void phase_prologue(const Params& p, char* smem) {
  int tid = threadIdx.x; asm volatile("" : "+v"(tid));
  float* mod = (float*)(p.ws + OFF_MOD);
  float* sc = (float*)smem;
  float* red = sc + 9 * 1024;
  for (int i = tid; i < 9 * 1024; i += 512) { const int r = i >> 10, k = i & 1023; const float v = r < 8 ? p.c[r * 1024 + k] : p.c_ctx[k]; sc[i] = siluf_(v); }
  __syncthreads();
  for (int it = blockIdx.x; it < DEPTH * NMOD * D / 128; it += gridDim.x) {
    const int l = it / (NMOD * D / 128), n0 = (it % (NMOD * D / 128)) * 128, c = tid & 127, ks = tid >> 7;
    const float* w = p.ada_w + (size_t)l * D * (NMOD * D) + n0 + c;
    float a[9];
#pragma unroll
    for (int r = 0; r < 9; ++r) a[r] = 0.f;
    for (int k = ks * 256; k < ks * 256 + 256; ++k) { const float wv = w[(size_t)k * (NMOD * D)];
#pragma unroll
      for (int r = 0; r < 9; ++r) a[r] += sc[r * 1024 + k] * wv; }
#pragma unroll
    for (int r = 0; r < 9; ++r) red[(ks * 9 + r) * 128 + c] = a[r];
    __syncthreads();
    for (int i = tid; i < 9 * 128; i += 512) { const int r = i >> 7, cc = i & 127;
      mod[((size_t)l * 9 + r) * (NMOD * D) + n0 + cc] = red[(0 * 9 + r) * 128 + cc] + red[(1 * 9 + r) * 128 + cc] + red[(2 * 9 + r) * 128 + cc] + red[(3 * 9 + r) * 128 + cc] + p.ada_b[l * NMOD * D + n0 + cc]; }
    __syncthreads();
  }
  const size_t gt = (size_t)blockIdx.x * 512 + tid, gn = (size_t)gridDim.x * 512;
  if (gt < 1024) {
    const int pos = (int)gt >> 4, i = (int)gt & 15; const float inv = exp2f(-(float)i * (13.287712379549449f / 16.f)), ang = (float)pos * inv;
    float s, c; s = sinf(ang); c = cosf(ang);
    ((float2*)(p.ws + OFF_ROPE))[gt] = make_float2(c, s);
  }
  if (gt < 2 * 512) {
    const int dir = (int)gt >> 9, k = (int)gt & 511; float lg[DEPTH], mx = -1e30f, sum = 0.f;
#pragma unroll
    for (int l = 0; l < DEPTH; ++l) { lg[l] = p.lb_logits[((size_t)dir * DEPTH + l) * 512 + k]; mx = fmaxf(mx, lg[l]); }
#pragma unroll
    for (int l = 0; l < DEPTH; ++l) { lg[l] = __expf(lg[l] - mx); sum += lg[l]; }
    float cum = 0.f; float* lb = (float*)(p.ws + OFF_LB);
#pragma unroll
    for (int l = 0; l < DEPTH; ++l) { if (l > 0) cum += lg[l] / sum; lb[((size_t)dir * DEPTH + l) * 512 + k] = cum; }
  }
  { const float4* s = (const float4*)p.ctx; float4* d = (float4*)(p.ws + OFF_HCTX); const size_t n = (size_t)NB * CTX * D / 4; for (size_t i = gt; i < n; i += gn) d[i] = s[i]; }
}

__device__ void wconv_tiles(const float* __restrict__ W, bf16_t* __restrict__ Wt, int K, int N, int item0, int& item_base, char* smem) {
  float* tile = (float*)smem;
  int tid = threadIdx.x; asm volatile("" : "+v"(tid));
  const int tk = K / 64, tn = N / 64, nt = tk * tn;
  int first = item_base; item_base += nt;
  int start = (bid_() - (first % (int)gridDim.x) + (int)gridDim.x) % (int)gridDim.x;
  const int tx = tid & 63, ty = tid >> 6, gstep = (int)gridDim.x;
  float cur[8];
  if (start < nt) { const int k0 = (start / tn) * 64, n0 = (start % tn) * 64;
#pragma unroll
    for (int i = 0; i < 8; ++i) cur[i] = W[(size_t)(k0 + ty * 8 + i) * N + n0 + tx]; }
  for (int t = start; t < nt; t += gstep) {
    const int k0 = (t / tn) * 64, n0 = (t % tn) * 64;
#pragma unroll
    for (int i = 0; i < 8; ++i) tile[(ty * 8 + i) * 65 + tx] = cur[i];
    if (t + gstep < nt) { const int k1 = ((t + gstep) / tn) * 64, n1 = ((t + gstep) % tn) * 64;
#pragma unroll
      for (int i = 0; i < 8; ++i) cur[i] = W[(size_t)(k1 + ty * 8 + i) * N + n1 + tx]; }
    __syncthreads();
    { const int kp = tid & 31, ng = tid >> 5;
#pragma unroll
      for (int i = 0; i < 4; ++i) { const int n = ng * 4 + i; *(unsigned*)(Wt + (size_t)(n0 + n) * K + k0 + kp * 2) = cvt_pk_bf16(tile[(kp * 2) * 65 + n], tile[(kp * 2 + 1) * 65 + n]); } }
    __syncthreads();
  }
  (void)item0;
}

__device__ void phase_wconv(const Params& p, int l, char* smem) {
  int base = 0;
  wconv_tiles(p.w_in + (size_t)l * D * PROJ, (bf16_t*)(p.ws + OFF_WIN), D, PROJ, 0, base, smem);
  wconv_tiles(p.w_a + (size_t)l * 512 * D, (bf16_t*)(p.ws + OFF_WA), 512, D, 0, base, smem);
  wconv_tiles(p.w_b + (size_t)l * 512 * D, (bf16_t*)(p.ws + OFF_WB), 512, D, 0, base, smem);
  wconv_tiles(p.w_c + (size_t)l * 512 * D, (bf16_t*)(p.ws + OFF_WC), 512, D, 0, base, smem);
  wconv_tiles(p.w_out + (size_t)l * D * D, (bf16_t*)(p.ws + OFF_WO), D, D, 0, base, smem);
  wconv_tiles(p.w1 + (size_t)l * D * DFF, (bf16_t*)(p.ws + OFF_W1), D, DFF, 0, base, smem);
  wconv_tiles(p.w2 + (size_t)l * DFF * D, (bf16_t*)(p.ws + OFF_W2), DFF, D, 0, base, smem);
}

__device__ void phase_norm(const Params& p, int l, int g, int which, int row_lo, int row_hi, int bid, int nb) {
  int tid = threadIdx.x; asm volatile("" : "+v"(tid));
  const int wave = tid >> 6, lane = tid & 63;
  const float* nw = (which ? p.norm2_w : p.norm1_w) + l * D;
  const float* mod = (const float*)(p.ws + OFF_MOD) + (size_t)l * 9 * NMOD * D;
  bf16_t* hn = (bf16_t*)(p.ws + OFF_HN);
  float4 vn[4]; int row = row_lo + bid * 8 + wave;
  auto src = [&](int r) -> const float* { int mr; const float* xr = resid_row(p, g, r, mr); if (l == 0 && which == 0 && r < MLAT) xr = p.x + (xr - p.out); return xr; };
  if (row < row_hi) { const float* xr = src(row);
#pragma unroll
    for (int j = 0; j < 4; ++j) vn[j] = *(const float4*)(xr + j * 256 + lane * 4); }
  for (; row < row_hi; row += nb * 8) {
    int modr; (void)resid_row(p, g, row, modr);
    const float* sh = mod + (size_t)modr * NMOD * D + (which ? 3 : 0) * D; const float* scl = sh + D;
    float4 v[4]; float ss = 0.f;
#pragma unroll
    for (int j = 0; j < 4; ++j) v[j] = vn[j];
    if (row + nb * 8 < row_hi) { const float* xr = src(row + nb * 8);
#pragma unroll
      for (int j = 0; j < 4; ++j) vn[j] = *(const float4*)(xr + j * 256 + lane * 4); }
    float4 w4[4], s14[4], s04[4];
#pragma unroll
    for (int j = 0; j < 4; ++j) { const int c = j * 256 + lane * 4; w4[j] = *(const float4*)(nw + c); s14[j] = *(const float4*)(scl + c); s04[j] = *(const float4*)(sh + c); }
#pragma unroll
    for (int j = 0; j < 4; ++j) ss += v[j].x * v[j].x + v[j].y * v[j].y + v[j].z * v[j].z + v[j].w * v[j].w;
#pragma unroll
    for (int o = 32; o > 0; o >>= 1) ss += __shfl_xor(ss, o);
    const float rstd = rsqrtf(ss * (1.f / D) + 1e-6f);
#pragma unroll
    for (int j = 0; j < 4; ++j) { const int c = j * 256 + lane * 4; const float4 w = w4[j], s1 = s14[j], s0 = s04[j];
      u32x2 o; o.x = cvt_pk_bf16(v[j].x * rstd * w.x * (1.f + s1.x) + s0.x, v[j].y * rstd * w.y * (1.f + s1.y) + s0.y);
      o.y = cvt_pk_bf16(v[j].z * rstd * w.z * (1.f + s1.z) + s0.z, v[j].w * rstd * w.w * (1.f + s1.w) + s0.w);
      *(u32x2*)(hn + (size_t)row * D + c) = o; }
  }
}

__device__ __forceinline__ void phase_gemm1(const Params& p, int nM, LAS unsigned char* lds) {
  const char* A = p.ws + OFF_HN; const char* Bt = p.ws + OFF_WIN; bf16_t* z = (bf16_t*)(p.ws + OFF_Z); u32x2* gates = (u32x2*)(p.ws + OFF_GATE);
  Sched<1> sc{nM, PROJ / BM, 0, 0};
  gemm_phase<true>(lds, D, D, sc, [=](const Unit&) { return A; }, [=](const Unit&) { return Bt; },
    [=] EPI_SIG { const int seg = u.pn >> 1;
      if (seg >= 11) {
        const int gp_ = u.pn - 22; u32x2* gt = gates + ((size_t)((gp_ >> 2) * (MG / 256) + u.pm) * 4 + (gp_ & 3)) * 32 * 512 + ((wr * 4 + wc) * 64 + fr) + (fq >> 1) * 512 + (fq & 1) * 32; asm volatile("" : "+v"(gt));
#pragma unroll
        for (int ai = 0; ai < 2; ++ai)
#pragma unroll
          for (int m = 0; m < 4; ++m)
#pragma unroll
            for (int bj = 0; bj < 2; ++bj)
#pragma unroll
              for (int n = 0; n < 2; ++n) { const f32x4 v = acc[ai][bj][m][n]; u32x2 o; o.x = cvt_pk_bf16(sigmoidf_(v[0]), sigmoidf_(v[1])); o.y = cvt_pk_bf16(sigmoidf_(v[2]), sigmoidf_(v[3]));
                gt[(ai * 16 + m * 4 + bj * 2) * 512 + n * 16] = o; }
      } else {
      EPI_LOOP(
        if (seg == 0 || seg == 4) { v[0] = siluf_(v[0]); v[1] = siluf_(v[1]); v[2] = siluf_(v[2]); v[3] = siluf_(v[3]); }
        u32x2 o; o.x = cvt_pk_bf16(v[0], v[1]); o.y = cvt_pk_bf16(v[2], v[3]);
        *(u32x2*)(z + (size_t)row * ZLD + (col - n * 16 - fq * 4 + fq * 8 + n * 4)) = o; ) } });
}

__device__ __forceinline__ void phase_merge(const Params& p, int pm0, int nM, int boff, LAS unsigned char* lds) {
  const u32x2* gates = (const u32x2*)(p.ws + OFF_GATE); bf16_t* mix = (bf16_t*)(p.ws + OFF_MIX);
  const char* Y = p.ws + OFF_Y; const char* W = p.ws + OFF_WA;
  Sched<3> sc{nM, D / BM, pm0, boff};
  gemm_phase<false>(lds, 512, 512, sc, [=](const Unit& u) { return Y + (size_t)u.br * MG * 512 * 2; }, [=](const Unit& u) { return W + (size_t)u.br * SZ_WBR; },
    [=] EPI_SIG { const int br = u.br; const u32x2* gtp = gates + ((size_t)(br * (MG / 256) + u.pm) * 4 + u.pn) * 32 * 512 + ((wr * 4 + wc) * 64 + fq * 16 + fr);
      u32x2 gt[2][4][2][2];
#pragma unroll
      for (int ai = 0; ai < 2; ++ai)
#pragma unroll
        for (int m = 0; m < 4; ++m)
#pragma unroll
          for (int bj = 0; bj < 2; ++bj)
#pragma unroll
            for (int n = 0; n < 2; ++n) gt[ai][m][bj][n] = gtp[(size_t)(ai * 16 + m * 4 + bj * 2 + n) * 512];
#pragma unroll
      for (int ai = 0; ai < 2; ++ai) {
        u32x2 pv[4][2][2];
#pragma unroll
        for (int m = 0; m < 4; ++m) { const int row = u.pm * BM + ai * HALF + wr * 64 + m * 16 + fr;
#pragma unroll
          for (int bj = 0; bj < 2; ++bj)
#pragma unroll
            for (int n = 0; n < 2; ++n) { const int col = u.pn * BM + bj * HALF + wc * 32 + n * 16 + fq * 4;
              if (br > 0) pv[m][bj][n] = __builtin_nontemporal_load((const u32x2*)(mix + (size_t)row * D + col)); else pv[m][bj][n] = (u32x2){0u, 0u}; } }
        asm volatile("" ::: "memory");
#pragma unroll
        for (int m = 0; m < 4; ++m) { const int row = u.pm * BM + ai * HALF + wr * 64 + m * 16 + fr;
#pragma unroll
          for (int bj = 0; bj < 2; ++bj)
#pragma unroll
            for (int n = 0; n < 2; ++n) { const int col = u.pn * BM + bj * HALF + wc * 32 + n * 16 + fq * 4; const f32x4 v = acc[ai][bj][m][n]; const u32x2 g2 = gt[ai][m][bj][n], p2 = pv[m][bj][n];
              u32x2 o; o.x = cvt_pk_bf16(bflo(g2.x) * v[0] + bflo(p2.x), bfhi(g2.x) * v[1] + bfhi(p2.x)); o.y = cvt_pk_bf16(bflo(g2.y) * v[2] + bflo(p2.y), bfhi(g2.y) * v[3] + bfhi(p2.y));
              *(u32x2*)(mix + (size_t)row * D + col) = o; } }
        asm volatile("" ::: "memory");
      } });
}

__device__ __forceinline__ void phase_gemm_resid(const Params& p, int l, int g, const char* A, int K, const char* Bt, int chunk, int pm0, int nM, int boff, LAS unsigned char* lds) {
  const float* mod = (const float*)(p.ws + OFF_MOD) + (size_t)l * 9 * NMOD * D + chunk * D;
  float* out = p.out; float* hctx = (float*)(p.ws + OFF_HCTX); const float* xin = p.x; const bool first = (l == 0 && chunk == 2);
  Sched<1> sc{nM, D / BM, pm0, boff};
  gemm_phase<true>(lds, K, K, sc, [=](const Unit&) { return A; }, [=](const Unit&) { return Bt; },
    [=] EPI_SIG {
      const int row0 = u.pm * BM + wr * 64 + fr; const bool lat = row0 < MLAT; const int modr = lat ? g * GB + (row0 >> 12) : 8;
      float* xb0 = lat ? out + ((size_t)modr * SEQ + (row0 & 4095)) * D : hctx + (size_t)(row0 - MLAT) * D;
      const float* xs0 = (first && lat) ? xin + (xb0 - out) : xb0;
      const int col0 = u.pn * BM + wc * 32 + fq * 8;
      f32x4 mv[2][2];
#pragma unroll
      for (int bj = 0; bj < 2; ++bj)
#pragma unroll
        for (int n = 0; n < 2; ++n) mv[bj][n] = *(const f32x4*)(mod + (size_t)modr * NMOD * D + col0 + bj * HALF + n * 4);
#pragma unroll
      for (int ai = 0; ai < 2; ++ai) {
        f32x4 xv[4][2][2];
#pragma unroll
        for (int m = 0; m < 4; ++m)
#pragma unroll
          for (int bj = 0; bj < 2; ++bj)
#pragma unroll
            for (int n = 0; n < 2; ++n) xv[m][bj][n] = *(const f32x4*)(xs0 + (size_t)(ai * HALF + m * 16) * D + col0 + bj * HALF + n * 4);
        asm volatile("" ::: "memory");
#pragma unroll
        for (int m = 0; m < 4; ++m)
#pragma unroll
          for (int bj = 0; bj < 2; ++bj)
#pragma unroll
            for (int n = 0; n < 2; ++n) *(f32x4*)(xb0 + (size_t)(ai * HALF + m * 16) * D + col0 + bj * HALF + n * 4) = xv[m][bj][n] + mv[bj][n] * acc[ai][bj][m][n];
        asm volatile("" ::: "memory");
      } });
}

__device__ __forceinline__ void phase_down_ctx(const Params& p, int l, LAS unsigned char* lds) {
  float* slab = (float*)(p.ws + OFF_SLAB);
  const char* A = p.ws + OFF_UC - (size_t)MLAT * DFF * 2; const char* Bt = p.ws + OFF_W2;
  SchedSplit2 sc;
  gemm_phase<false>(lds, 2048, DFF, sc, [=](const Unit& u) { return A + (size_t)u.br * 4096; }, [=](const Unit& u) { return Bt + (size_t)u.br * 4096; },
    [=] EPI_SIG { float* sl = slab + (size_t)u.br * MCTX * D;
      EPI_LOOP( *(f32x4*)(sl + (size_t)(row - MLAT) * D + col) = v; ) });
  (void)l;
}
__device__ __forceinline__ void phase_down_ctx_combine(const Params& p, int l, int bid, int tid) {
  const float* mod = (const float*)(p.ws + OFF_MOD) + ((size_t)l * 9 + 8) * NMOD * D + 5 * D;
  const f32x4* s0 = (const f32x4*)(p.ws + OFF_SLAB); const f32x4* s1 = s0 + (size_t)MCTX * D / 4; f32x4* hc = (f32x4*)(p.ws + OFF_HCTX);
  for (int i = bid * 512 + tid; i < MCTX * D / 4; i += (int)gridDim.x * 512) { const f32x4 mv = *(const f32x4*)(mod + (i & 255) * 4); hc[i] += mv * (s0[i] + s1[i]); }
}

template <class SC>
__device__ __forceinline__ void phase_up(const Params& p, bf16_t* uo, const SC& sc, LAS unsigned char* lds) {
  const char* A = p.ws + OFF_HN; const char* Bt = p.ws + OFF_W1;
  gemm_phase<true>(lds, D, D, sc, [=](const Unit&) { return A; }, [=](const Unit&) { return Bt; },
    [=] EPI_SIG {
      EPI_LOOP(
        float r0 = fmaxf(v[0], 0.f); float r1 = fmaxf(v[1], 0.f); float r2 = fmaxf(v[2], 0.f); float r3 = fmaxf(v[3], 0.f);
        u32x2 o; o.x = cvt_pk_bf16(r0 * r0, r1 * r1); o.y = cvt_pk_bf16(r2 * r2, r3 * r3);
        *(u32x2*)(uo + (size_t)row * DFF + (col - n * 16 - fq * 4 + fq * 8 + n * 4)) = o; ) });
}

__device__ __forceinline__ bf16x8 lds_frag(const char* base, int row, int pitch_b, int colb) { return *(const bf16x8*)(base + row * pitch_b + colb); }

__device__ __forceinline__ void tokblock_item(const Params& p, int l, int it, char* smem, int tid, bool do_prep) {
  bf16_t* z = (bf16_t*)(p.ws + OFF_Z);
  const int row0 = it * 64, wave = tid >> 6, lane = tid & 63;
  const bool is_ctx = row0 >= MLAT;
  if (do_prep) {
    const float2* rope = (const float2*)(p.ws + OFF_ROPE);
    const int s = lane & 7, ax = s >> 2, hf = (s >> 1) & 1;
    float qw[8], kw[8];
#pragma unroll
    for (int j = 0; j < 8; ++j) { qw[j] = p.qn_w[l * 64 + s * 8 + j]; kw[j] = p.kn_w[l * 64 + s * 8 + j]; }
    u32x4 rawqk[8][2];
#pragma unroll
    for (int tt = 0; tt < 8; ++tt)
#pragma unroll
      for (int which = 0; which < 2; ++which) rawqk[tt][which] = *(const u32x4*)(z + (size_t)(row0 + wave * 8 + tt) * ZLD + (which ? ZNK : ZNQ) + lane * 8);
#pragma unroll
    for (int tt = 0; tt < 8; ++tt) {
      const int row = row0 + wave * 8 + tt, t = row & 4095, pos = ax ? (t & 63) : (t >> 6);
#pragma unroll
      for (int which = 0; which < 2; ++which) {
        bf16_t* ptr = z + (size_t)row * ZLD + (which ? ZNK : ZNQ) + lane * 8;
        const u32x4 raw = rawqk[tt][which];
        float y[8] = {bflo(raw.x), bfhi(raw.x), bflo(raw.y), bfhi(raw.y), bflo(raw.z), bfhi(raw.z), bflo(raw.w), bfhi(raw.w)};
        float ss = 0.f;
#pragma unroll
        for (int j = 0; j < 8; ++j) ss += y[j] * y[j];
        ss += __shfl_xor(ss, 1); ss += __shfl_xor(ss, 2); ss += __shfl_xor(ss, 4);
        const float rstd = rsqrtf(ss * (1.f / 64.f) + 1e-6f) ;
#pragma unroll
        for (int j = 0; j < 8; ++j) y[j] = y[j] * rstd * (which ? kw[j] : qw[j]);
        if (!is_ctx) {
#pragma unroll
          for (int j = 0; j < 8; ++j) { const float yp = __shfl_xor(y[j], 2); const float2 cs = rope[pos * 16 + (s & 1) * 8 + j]; y[j] = y[j] * cs.x + (hf ? yp : -yp) * cs.y; }
        }
        if (which == 0) {
#pragma unroll
          for (int j = 0; j < 8; ++j) y[j] *= 0.18033688011112042f;
        }
        u32x4 o; o.x = cvt_pk_bf16(y[0], y[1]); o.y = cvt_pk_bf16(y[2], y[3]); o.z = cvt_pk_bf16(y[4], y[5]); o.w = cvt_pk_bf16(y[6], y[7]);
        *(u32x4*)ptr = o;
      }
    }
  }
  {
    bf16_t* Vl = (bf16_t*)smem;
    { u32x4 tv[8];
#pragma unroll
      for (int i = 0; i < 8; ++i) { const int q = tid + i * 512, tok = q >> 6, cg = q & 63; tv[i] = *(const u32x4*)(z + (size_t)(row0 + tok) * ZLD + ZNV + cg * 8); }
#pragma unroll
      for (int i = 0; i < 8; ++i) { const int q = tid + i * 512, tok = q >> 6, cg = q & 63; *(u32x4*)(Vl + tok * 520 + cg * 8) = tv[i]; } }
    __syncthreads();
    const int bl = is_ctx ? ((row0 - MLAT) >> 8) : (row0 >> 12), TOKS = is_ctx ? CTX : SEQ;
    const int tokpos = is_ctx ? ((row0 - MLAT) & 255) : (row0 & 4095);
    bf16_t* vt = (bf16_t*)(p.ws + (is_ctx ? OFF_VTC : OFF_VT)) + (size_t)bl * 512 * TOKS + tokpos;
#pragma unroll
    for (int i = 0; i < 8; ++i) { const int q = tid + i * 512, tg = q & 7, c = q >> 3;
      unsigned short e[8];
#pragma unroll
      for (int j = 0; j < 8; ++j) e[j] = Vl[(tg * 8 + j) * 520 + c];
      u32x4 o; o.x = e[0] | ((unsigned)e[1] << 16); o.y = e[2] | ((unsigned)e[3] << 16); o.z = e[4] | ((unsigned)e[5] << 16); o.w = e[6] | ((unsigned)e[7] << 16);
      *(u32x4*)(vt + (size_t)c * TOKS + tg * 8) = o; }
    __syncthreads();
  }
  {
    bf16_t* yc = (bf16_t*)(p.ws + OFF_Y) + (size_t)2 * MG * 512;
    const float* cw = p.conv_w + (size_t)l * 3 * 512;
#pragma unroll 4
    for (int i = 0; i < 8; ++i) { const int q = tid + i * 512, cg = q & 63, row = row0 + (q >> 6);
      const int pos = is_ctx ? ((row - MLAT) & 255) : (row & 4095), len = is_ctx ? CTX : SEQ;
      const bf16_t* zr = z + (size_t)row * ZLD + cg * 8;
      const u32x4 bb = *(const u32x4*)(zr + ZCB);
      u32x4 cc[3], xx[3];
#pragma unroll
      for (int d = 0; d < 3; ++d) { const bool ok = (d == 1) || (d == 0 ? pos > 0 : pos < len - 1);
        if (ok) { cc[d] = *(const u32x4*)(zr + (ptrdiff_t)(d - 1) * ZLD + ZCC); xx[d] = *(const u32x4*)(zr + (ptrdiff_t)(d - 1) * ZLD + ZCX); }
        else { cc[d] = (u32x4){0, 0, 0, 0}; xx[d] = (u32x4){0, 0, 0, 0}; } }
      float r[8];
#pragma unroll
      for (int j = 0; j < 8; ++j) { const int ch = cg * 8 + j; float acc = 0.f;
#pragma unroll
        for (int d = 0; d < 3; ++d) { const unsigned cu = cc[d][j >> 1], xu = xx[d][j >> 1]; const float cv = (j & 1) ? bfhi(cu) : bflo(cu), xv = (j & 1) ? bfhi(xu) : bflo(xu); acc += cw[d * 512 + ch] * (cv * xv); }
        const unsigned bu = bb[j >> 1]; r[j] = ((j & 1) ? bfhi(bu) : bflo(bu)) * acc; }
      u32x4 o; o.x = cvt_pk_bf16(r[0], r[1]); o.y = cvt_pk_bf16(r[2], r[3]); o.z = cvt_pk_bf16(r[4], r[5]); o.w = cvt_pk_bf16(r[6], r[7]);
      *(u32x4*)(yc + (size_t)row * 512 + cg * 8) = o; }
  }
}

constexpr int H_QS = 0, H_QI = 17408, H_KS = 34816, H_KHT = 52224, H_VTL = 70656, H_ST = 89088, H_PL = 123904, H_PSUM = 133120, H_DC = 137216;
constexpr int P136 = 272, P72 = 144;

struct HRaw { unsigned f[8], v[8], q[8]; };
template <bool FULL>
__device__ __forceinline__ void hgrn_load(HRaw& r, const bf16_t* __restrict__ z, int h, int dir, int rowbase, int c, int tid) {
  const int kp = tid & 63, part = tid >> 6, k0 = 2 * kp;
#pragma unroll
  for (int e = 0; e < 8; ++e) { const int tau = c * 64 + part * 8 + e, row = rowbase + (dir ? 255 - tau : tau);
    const bf16_t* zr = z + (size_t)row * ZLD + h * 128 + k0;
    r.f[e] = *(const unsigned*)(zr + (dir ? ZFB : ZFF)); r.v[e] = *(const unsigned*)(zr + ZI);
    if (FULL) r.q[e] = *(const unsigned*)(zr + ZQ); }
}
template <bool FULL>
__device__ __forceinline__ float2 hgrn_prep(const HRaw& r, const float* __restrict__ lbv, int h, char* smem, int tid) {
  const int kp = tid & 63, part = tid >> 6, k0 = 2 * kp;
  const float lb0 = lbv[h * 128 + k0], lb1 = lbv[h * 128 + k0 + 1];
  float lg0[8], lg1[8], kk0[8], kk1[8]; unsigned qr[8], vr[8];
  float s0 = 0.f, s1 = 0.f;
#pragma unroll
  for (int e = 0; e < 8; ++e) {
    const unsigned fr_ = r.f[e]; vr[e] = r.v[e];
    if (FULL) qr[e] = r.q[e];
    const float g0 = lb0 + (1.f - lb0) * sigmoidf_(bflo(fr_)), g1 = lb1 + (1.f - lb1) * sigmoidf_(bfhi(fr_));
    lg0[e] = __logf(g0); lg1[e] = __logf(g1); kk0[e] = 1.f - g0; kk1[e] = 1.f - g1; s0 += lg0[e]; s1 += lg1[e]; }
  float* psum = (float*)(smem + H_PSUM);
  psum[part * 128 + k0] = s0; psum[part * 128 + k0 + 1] = s1;
  __syncthreads();
  float pre0 = 0.f, pre1 = 0.f, tot0 = 0.f, tot1 = 0.f, gm0 = 0.f, gm1 = 0.f;
#pragma unroll
  for (int pp = 0; pp < 8; ++pp) { const float a = psum[pp * 128 + k0], b = psum[pp * 128 + k0 + 1]; tot0 += a; tot1 += b; if (pp < part) { pre0 += a; pre1 += b; } if (pp < 4) { gm0 += a; gm1 += b; } }
  unsigned kh0[4], kh1[4], v0[4], v1[4]; float pk0 = 0.f, pk1 = 0.f; unsigned pv0 = 0, pv1 = 0;
  float G0 = pre0, G1 = pre1;
#pragma unroll
  for (int e = 0; e < 8; ++e) { G0 += lg0[e]; G1 += lg1[e]; const int tau = part * 8 + e;
    if (FULL) {
      const float q0 = bflo(qr[e]), q1 = bfhi(qr[e]);
      *(unsigned*)(smem + H_QS + tau * P136 + k0 * 2) = cvt_pk_bf16(q0 * __expf(fminf(G0 - gm0, 80.f)), q1 * __expf(fminf(G1 - gm1, 80.f)));
      *(unsigned*)(smem + H_QI + tau * P136 + k0 * 2) = cvt_pk_bf16(q0 * __expf(G0), q1 * __expf(G1));
      *(unsigned*)(smem + H_KS + tau * P136 + k0 * 2) = cvt_pk_bf16(kk0[e] * __expf(fminf(gm0 - G0, 80.f)), kk1[e] * __expf(fminf(gm1 - G1, 80.f)));
    }
    const float a0 = kk0[e] * __expf(tot0 - G0), a1 = kk1[e] * __expf(tot1 - G1);
    if (e & 1) { kh0[e >> 1] = cvt_pk_bf16(pk0, a0); kh1[e >> 1] = cvt_pk_bf16(pk1, a1); v0[e >> 1] = (pv0 & 0xffffu) | (vr[e] << 16); v1[e >> 1] = (pv1 >> 16) | (vr[e] & 0xffff0000u); }
    else { pk0 = a0; pk1 = a1; pv0 = vr[e]; pv1 = vr[e]; } }
  *(u32x4*)(smem + H_KHT + k0 * P72 + part * 16) = (u32x4){kh0[0], kh0[1], kh0[2], kh0[3]};
  *(u32x4*)(smem + H_KHT + (k0 + 1) * P72 + part * 16) = (u32x4){kh1[0], kh1[1], kh1[2], kh1[3]};
  *(u32x4*)(smem + H_VTL + k0 * P72 + part * 16) = (u32x4){v0[0], v0[1], v0[2], v0[3]};
  *(u32x4*)(smem + H_VTL + (k0 + 1) * P72 + part * 16) = (u32x4){v1[0], v1[1], v1[2], v1[3]};
  if (part == 0) { float* dc = (float*)(smem + H_DC); dc[k0] = __expf(tot0); dc[k0 + 1] = __expf(tot1); }
  return make_float2(tot0, tot1);
}

__device__ __forceinline__ void hgrn_state_update(f32x4 (&S)[8], const char* smem, int w, int fr, int fq) {
  const float* dc = (const float*)(smem + H_DC); const f32x4 d4 = *(const f32x4*)(dc + 16 * w + fq * 4);
#pragma unroll
  for (int n = 0; n < 8; ++n) S[n] *= d4;
#pragma unroll
  for (int ks = 0; ks < 2; ++ks) { const bf16x8 a = lds_frag(smem + H_KHT, 16 * w + fr, P72, ks * 64 + fq * 16);
#pragma unroll
    for (int n = 0; n < 8; ++n) S[n] = __builtin_amdgcn_mfma_f32_16x16x32_bf16(a, lds_frag(smem + H_VTL, n * 16 + fr, P72, ks * 64 + fq * 16), S[n], 0, 0, 0); }
}

__device__ __forceinline__ int hgrn_block_row(int bl, int dir, int j) { return bl * SEQ + (dir ? 16 - j : j - 1) * 256; }

__device__ __forceinline__ void hgrn_local_item(const Params& p, int l, int it, char* smem, int tid) {
  const bool isc = it >= 480; const int ic = it - 480;
  const int j = isc ? 0 : 1 + it % 15, dir = isc ? (ic & 1) : (it / 15) & 1, h = isc ? (ic >> 1) & 3 : (it / 30) & 3, bl = isc ? (ic >> 3) : it / 120, chain = (bl * 4 + h) * 2 + dir;
  const bf16_t* z = (const bf16_t*)(p.ws + OFF_Z); const float* lbv = (const float*)(p.ws + OFF_LB) + ((size_t)dir * DEPTH + l) * 512;
  const int w = tid >> 6, lane = tid & 63, fr = lane & 15, fq = lane >> 4, rowbase = isc ? MLAT + bl * CTX : hgrn_block_row(bl, dir, j);
  f32x4 S[8];
#pragma unroll
  for (int n = 0; n < 8; ++n) S[n] = (f32x4){0.f, 0.f, 0.f, 0.f};
  float ld0 = 0.f, ld1 = 0.f;
  HRaw raw; hgrn_load<false>(raw, z, h, dir, rowbase, 0, tid);
  for (int c = 0; c < 4; ++c) {
    const float2 tt = hgrn_prep<false>(raw, lbv, h, smem, tid); ld0 += tt.x; ld1 += tt.y;
    if (c < 3) hgrn_load<false>(raw, z, h, dir, rowbase, c + 1, tid);
    __syncthreads();
    hgrn_state_update(S, smem, w, fr, fq);
    __syncthreads();
  }
  float* Lb = isc ? (float*)(p.ws + OFF_LCTX) + (size_t)chain * 16384 : (float*)(p.ws + OFF_MIX) + ((size_t)chain * NSC + j) * 16384;
#pragma unroll
  for (int n = 0; n < 8; ++n)
#pragma unroll
    for (int jj = 0; jj < 4; ++jj) Lb[(16 * w + fq * 4 + jj) * 128 + n * 16 + fr] = S[n][jj];
  if (tid < 64) { float* hd = isc ? (float*)(p.ws + OFF_HDC) + (size_t)chain * 128 : (float*)(p.ws + OFF_HD) + ((size_t)chain * NSC + j) * 128; hd[2 * tid] = __expf(ld0); hd[2 * tid + 1] = __expf(ld1); }
}

__device__ __forceinline__ void hgrn_out_item(const Params& p, int l, int g, int it, char* smem, int tid) {
  const bool isc = it >= 256; const int ic = it - 256;
  const int pb = isc ? 0 : 1 + (it & 15), h = isc ? (ic & 3) : (it >> 4) & 3, bl = isc ? (ic >> 2) : it >> 6, bglob = isc ? bl : g * GB + bl;
  const bf16_t* z = (const bf16_t*)(p.ws + OFF_Z); bf16_t* ya = (bf16_t*)(p.ws + OFF_Y);
  const int w = tid >> 6, lane = tid & 63, fr = lane & 15, fq = lane >> 4;
  const int rowbase = isc ? MLAT + bl * CTX : bl * SEQ + (pb - 1) * 256;
  const float* onw = p.onorm_w + l * 128;
  for (int dir = 0; dir < 2; ++dir) {
    const int chain = (bl * 4 + h) * 2 + dir, j = pb == 0 ? 0 : (dir ? 17 - pb : pb);
    const float* lbv = (const float*)(p.ws + OFF_LB) + ((size_t)dir * DEPTH + l) * 512;
    f32x4 S[8];
#pragma unroll
    for (int n = 0; n < 8; ++n) S[n] = (f32x4){0.f, 0.f, 0.f, 0.f};
    const int cchain = (bglob * 4 + h) * 2 + dir;
    { f32x4 Ln[8], dn;
#define HC_LOAD(i_) do { const int _i = (i_); const float* Lb = _i == 0 ? (const float*)(p.ws + OFF_LCTX) + (size_t)cchain * 16384 : (const float*)(p.ws + OFF_MIX) + ((size_t)chain * NSC + _i) * 16384; \
        dn = *(const f32x4*)((_i == 0 ? (const float*)(p.ws + OFF_HDC) + (size_t)cchain * 128 : (const float*)(p.ws + OFF_HD) + ((size_t)chain * NSC + _i) * 128) + 16 * w + fq * 4); \
        const float* _lp = Lb + (16 * w + fq * 4) * 128 + fr; asm volatile("" : "+v"(_lp)); \
        _Pragma("unroll") for (int n = 0; n < 8; ++n) _Pragma("unroll") for (int jj = 0; jj < 4; ++jj) Ln[n][jj] = _lp[jj * 128 + n * 16]; } while (0)
      if (j > 0) HC_LOAD(0);
      for (int i = 0; i < j; ++i) {
        f32x4 Lc[8]; const f32x4 dc4 = dn;
#pragma unroll
        for (int n = 0; n < 8; ++n) Lc[n] = Ln[n];
        if (i + 1 < j) HC_LOAD(i + 1);
#pragma unroll
        for (int n = 0; n < 8; ++n) S[n] = dc4 * S[n] + Lc[n];
      }
#undef HC_LOAD
    }
    HRaw raw; hgrn_load<false>(raw, z, h, dir, rowbase, 0, tid);
    for (int c = 0; c < 4; ++c) {
      { const int kp_ = tid & 63, part_ = tid >> 6;
#pragma unroll
        for (int e = 0; e < 8; ++e) { const int tau = c * 64 + part_ * 8 + e, row = rowbase + (dir ? 255 - tau : tau); raw.q[e] = *(const unsigned*)(z + (size_t)row * ZLD + h * 128 + 2 * kp_ + ZQ); } }
      hgrn_prep<true>(raw, lbv, h, smem, tid);
      u32x4 gq0 = {0, 0, 0, 0}, gq1 = {0, 0, 0, 0};
      if (dir == 1) {
        const bf16_t* gp = z + (size_t)(rowbase + 255 - (c * 64 + (tid >> 3))) * ZLD + ZG + h * 128 + (tid & 7) * 16;
        gq0 = *(const u32x4*)gp; gq1 = *(const u32x4*)(gp + 8);
      }
#pragma unroll
      for (int n = 0; n < 8; ++n) { u32x2 o; o.x = cvt_pk_bf16(S[n][0], S[n][1]); o.y = cvt_pk_bf16(S[n][2], S[n][3]); *(u32x2*)(smem + H_ST + (n * 16 + fr) * P136 + (16 * w + fq * 4) * 2) = o; }
      __syncthreads();
      {
        const int mt = w & 3;
        f32x4 pa[2] = {(f32x4){0.f, 0.f, 0.f, 0.f}, (f32x4){0.f, 0.f, 0.f, 0.f}};
#pragma unroll
        for (int ks = 0; ks < 4; ++ks) { const bf16x8 a = lds_frag(smem + H_QS, mt * 16 + fr, P136, ks * 64 + fq * 16);
#pragma unroll
          for (int e = 0; e < 2; ++e) pa[e] = __builtin_amdgcn_mfma_f32_16x16x32_bf16(a, lds_frag(smem + H_KS, ((w >> 2) * 2 + e) * 16 + fr, P136, ks * 64 + fq * 16), pa[e], 0, 0, 0); }
#pragma unroll
        for (int e = 0; e < 2; ++e) { const int sx = ((w >> 2) * 2 + e) * 16 + fr;
#pragma unroll
          for (int jj = 0; jj < 4; ++jj) { const int t = mt * 16 + fq * 4 + jj; *(bf16_t*)(smem + H_PL + t * P72 + sx * 2) = f2bf(sx <= t ? pa[e][jj] : 0.f); } }
      }
      __syncthreads();
      f32x4 O[4];
      { const int mt = w & 3, nh = w >> 2;
#pragma unroll
        for (int n = 0; n < 4; ++n) O[n] = (f32x4){0.f, 0.f, 0.f, 0.f};
#pragma unroll
        for (int ks = 0; ks < 4; ++ks) { const bf16x8 a = lds_frag(smem + H_QI, mt * 16 + fr, P136, ks * 64 + fq * 16);
#pragma unroll
          for (int n = 0; n < 4; ++n) O[n] = __builtin_amdgcn_mfma_f32_16x16x32_bf16(a, lds_frag(smem + H_ST, (nh * 4 + n) * 16 + fr, P136, ks * 64 + fq * 16), O[n], 0, 0, 0); }
#pragma unroll
        for (int ks = 0; ks < 2; ++ks) { const bf16x8 a = lds_frag(smem + H_PL, mt * 16 + fr, P72, ks * 64 + fq * 16);
#pragma unroll
          for (int n = 0; n < 4; ++n) O[n] = __builtin_amdgcn_mfma_f32_16x16x32_bf16(a, lds_frag(smem + H_VTL, (nh * 4 + n) * 16 + fr, P72, ks * 64 + fq * 16), O[n], 0, 0, 0); }
      }
      if (c < 3) { hgrn_state_update(S, smem, w, fr, fq); hgrn_load<false>(raw, z, h, dir, rowbase, c + 1, tid); }
      __syncthreads();
      { const int mt = w & 3, nh = w >> 2;
        float* Ot = (float*)(smem + H_ST);
        const int t0 = mt * 16 + fq * 4, v0 = nh * 64 + fr, tau0 = c * 64 + t0;
        bf16_t* yp0 = ya + (size_t)(rowbase + (dir ? 255 - tau0 : tau0)) * 512 + h * 128 + v0; asm volatile("" : "+v"(yp0));
        const int rstep = dir ? -512 : 512;
        if (dir == 0) {
#pragma unroll
          for (int n = 0; n < 4; ++n)
#pragma unroll
            for (int jj = 0; jj < 4; ++jj) yp0[jj * rstep + n * 16] = f2bf(O[n][jj]);
        } else {
          bf16_t yv[4][4];
#pragma unroll
          for (int n = 0; n < 4; ++n)
#pragma unroll
            for (int jj = 0; jj < 4; ++jj) yv[n][jj] = yp0[jj * rstep + n * 16];
#pragma unroll
          for (int n = 0; n < 4; ++n)
#pragma unroll
            for (int jj = 0; jj < 4; ++jj) Ot[(t0 + jj) * 132 + nh * 64 + n * 16 + fr] = O[n][jj] + bf2f(yv[n][jj]);
        }
      }
      __syncthreads();
      if (dir == 1) {
        const float* Ot = (const float*)(smem + H_ST);
        const int t = tid >> 3, vs = tid & 7, tau = c * 64 + t, row = rowbase + 255 - tau;
        float o[16]; float ss = 0.f;
#pragma unroll
        for (int i = 0; i < 16; ++i) { o[i] = Ot[t * 132 + vs * 16 + i]; ss += o[i] * o[i]; }
        ss += __shfl_xor(ss, 1); ss += __shfl_xor(ss, 2); ss += __shfl_xor(ss, 4);
        const float rstd = rsqrtf(ss * (1.f / 128.f) + 1e-6f);
        const u32x4 g0 = gq0, g1 = gq1;
        const unsigned gu[8] = {g0.x, g0.y, g0.z, g0.w, g1.x, g1.y, g1.z, g1.w}; unsigned ou[8];
#pragma unroll
        for (int i = 0; i < 8; ++i) ou[i] = cvt_pk_bf16(o[2 * i] * rstd * onw[vs * 16 + 2 * i] * bflo(gu[i]), o[2 * i + 1] * rstd * onw[vs * 16 + 2 * i + 1] * bfhi(gu[i]));
        bf16_t* yp = ya + (size_t)row * 512 + h * 128 + vs * 16;
        *(u32x4*)yp = (u32x4){ou[0], ou[1], ou[2], ou[3]}; *(u32x4*)(yp + 8) = (u32x4){ou[4], ou[5], ou[6], ou[7]};
        __syncthreads();
      }
    }
    __syncthreads();
  }
}

constexpr int NK = 832, KP = 144  , VP = 1680  , N_RPB = 122880;
__device__ __forceinline__ void natten_item(const Params& p, int l, int bl, int bg, int h, int rp, bool ctxq, char* smem, int tid) {
  const bf16_t* z = (const bf16_t*)(p.ws + OFF_Z);
  const int w = tid >> 6, lane = tid & 63, fr = lane & 15, fq = lane >> 4;
  const int r = 2 * rp + (w >> 2), jb = w & 3;
  const int r0 = min(max(r - 4, 0), 56), rlo = min(max(2 * rp - 4, 0), 56);
  const int cs = jb == 0 ? 0 : (jb == 1 ? 8 : (jb == 2 ? 24 : 32));
  { u32x4 tk[13];
#pragma unroll
    for (int i = 0; i < 13; ++i) { const int q = tid + i * 512, kr = q >> 3, pc = q & 7; int row;
      if (kr < 576) { const int br = min(rlo + (kr >> 6), 63); row = bl * SEQ + br * 64 + (kr & 63); } else row = MLAT + bg * CTX + (kr - 576);
      if (i >= 9 || !ctxq) tk[i] = *(const u32x4*)(z + (size_t)row * ZLD + ZNK + h * 64 + pc * 8); }
#pragma unroll
    for (int i = 0; i < 13; ++i) { const int q = tid + i * 512, kr = q >> 3, pc = q & 7;
      if (i >= 9 || !ctxq) *(u32x4*)(smem + kr * KP + pc * 16) = tk[i]; } }
  float* rpbs = (float*)(smem + N_RPB);
  for (int q = tid; q < 15 * 31; q += 512) rpbs[q] = p.rpb[((size_t)l * 8 + h) * 465 + q] * 1.4426950408889634f;
  const int qrow = ctxq ? (MLAT + bg * CTX + rp * 128 + w * 16 + fr) : (bl * SEQ + r * 64 + jb * 16 + fr);
  bf16x8 qf[2];
#pragma unroll
  for (int ks = 0; ks < 2; ++ks) qf[ks] = *(const bf16x8*)(z + (size_t)qrow * ZLD + ZNQ + h * 64 + ks * 32 + fq * 8);
  __syncthreads();
  f32x4 S[32];
#pragma unroll
  for (int ti = 0; ti < 32; ++ti) {
    S[ti] = (f32x4){0.f, 0.f, 0.f, 0.f};
    if (ti >= 16 || !ctxq) {
      const int base = ti < 16 ? ((r0 - rlo + (ti >> 1)) * 64 + cs + (ti & 1) * 16) : (576 + (ti - 16) * 16);
#pragma unroll
      for (int ks = 0; ks < 2; ++ks) S[ti] = __builtin_amdgcn_mfma_f32_16x16x32_bf16(lds_frag(smem, base + fr, KP, ks * 64 + fq * 16), qf[ks], S[ti], 0, 0, 0);
    }
    if ((ti & 3) == 3) __builtin_amdgcn_sched_barrier(0);
  }
  float mx = -1e30f;
  { const int c = jb * 16 + fr, cst = min(max(c - 8, 0), 48);
#pragma unroll
    for (int ti = 0; ti < 16; ++ti) {
#pragma unroll
      for (int jj = 0; jj < 4; ++jj) { const int kc = cs + (ti & 1) * 16 + fq * 4 + jj; const bool ok = !ctxq && kc >= cst && kc < cst + 16;
        const int rb = r0 + (ti >> 1) - r + 7, cb = min(max(kc - c + 15, 0), 30);
        S[ti][jj] = ok ? S[ti][jj] + rpbs[rb * 31 + cb] : -1e30f; mx = fmaxf(mx, S[ti][jj]); }
      if (ti & 1) __builtin_amdgcn_sched_barrier(0); }
#pragma unroll
    for (int ti = 16; ti < 32; ++ti)
#pragma unroll
      for (int jj = 0; jj < 4; ++jj) mx = fmaxf(mx, S[ti][jj]);
  }
  mx = fmaxf(mx, __shfl_xor(mx, 16)); mx = fmaxf(mx, __shfl_xor(mx, 32));
  float sum = 0.f;
#pragma unroll
  for (int ti = 0; ti < 32; ++ti)
#pragma unroll
    for (int jj = 0; jj < 4; ++jj) { const float e = __builtin_amdgcn_exp2f(S[ti][jj] - mx); S[ti][jj] = e; sum += e; }
  sum += __shfl_xor(sum, 16); sum += __shfl_xor(sum, 32);
  __syncthreads();
  { const bf16_t* vt = (const bf16_t*)(p.ws + OFF_VT) + ((size_t)(bl * 8 + h) * 64) * SEQ; const bf16_t* vtc = (const bf16_t*)(p.ws + OFF_VTC) + ((size_t)(bg * 8 + h) * 64) * CTX;
#pragma unroll
    for (int hb = 0; hb < 2; ++hb) { u32x4 tv[7];
#pragma unroll
      for (int i = 0; i < 7; ++i) { const int q = tid + (hb * 7 + i) * 512, d = q / 104, pc = q % 104;
        if (hb * 7 + i < 13) { if (pc >= 72) tv[i] = *(const u32x4*)(vtc + (size_t)d * CTX + (pc - 72) * 8);
          else if (!ctxq) tv[i] = *(const u32x4*)(vt + (size_t)d * SEQ + min(rlo * 64 + pc * 8, SEQ - 8)); } }
#pragma unroll
      for (int i = 0; i < 7; ++i) { const int q = tid + (hb * 7 + i) * 512, d = q / 104, pc = q % 104;
        if (hb * 7 + i < 13) { if (pc >= 72 || !ctxq) *(u32x4*)(smem + d * VP + pc * 16) = tv[i]; } } } }
  __syncthreads();
  f32x4 O[4];
#pragma unroll
  for (int dt = 0; dt < 4; ++dt) O[dt] = (f32x4){0.f, 0.f, 0.f, 0.f};
#pragma unroll
  for (int u = 0; u < 16; ++u) {
    if (u >= 8 || !ctxq) {
      const int tA = 2 * u, tB = 2 * u + 1;
      const int bA = tA < 16 ? ((r0 - rlo + (tA >> 1)) * 64 + cs + (tA & 1) * 16) : (576 + (tA - 16) * 16);
      const int bB = tB < 16 ? ((r0 - rlo + (tB >> 1)) * 64 + cs + (tB & 1) * 16) : (576 + (tB - 16) * 16);
      union { bf16x8 v; unsigned u4[4]; } pf;
      pf.u4[0] = cvt_pk_bf16(S[tA][0], S[tA][1]); pf.u4[1] = cvt_pk_bf16(S[tA][2], S[tA][3]); pf.u4[2] = cvt_pk_bf16(S[tB][0], S[tB][1]); pf.u4[3] = cvt_pk_bf16(S[tB][2], S[tB][3]);
#pragma unroll
      for (int dt = 0; dt < 4; ++dt) {
        union { bf16x8 v; u32x2 h2[2]; } vf;
        vf.h2[0] = *(const u32x2*)(smem + (dt * 16 + fr) * VP + (bA + fq * 4) * 2);
        vf.h2[1] = *(const u32x2*)(smem + (dt * 16 + fr) * VP + (bB + fq * 4) * 2);
        O[dt] = __builtin_amdgcn_mfma_f32_16x16x32_bf16(vf.v, pf.v, O[dt], 0, 0, 0);
      }
    }
    __builtin_amdgcn_sched_barrier(0);
  }
  const float inv = 1.f / sum;
  bf16_t* yb = (bf16_t*)(p.ws + OFF_Y) + (size_t)MG * 512 + (size_t)qrow * 512 + h * 64;
#pragma unroll
  for (int dt = 0; dt < 4; ++dt) { u32x2 o; o.x = cvt_pk_bf16(O[dt][0] * inv, O[dt][1] * inv); o.y = cvt_pk_bf16(O[dt][2] * inv, O[dt][3] * inv); *(u32x2*)(yb + dt * 16 + fq * 4) = o; }
  __syncthreads();
}

#define QUEUE_LOOP(n_items_, ...) do { \
    unsigned* _qc = (unsigned*)(p.ws + OFF_BAR + 3456 * 4) + ph; volatile unsigned* _slot = (volatile unsigned*)(smem + LDS_TOP - 8); \
    int it = bid_(); \
    while (it < (n_items_)) { asm volatile("" : "+v"(tid)); __VA_ARGS__ \
      __syncthreads(); if (tid == 0) *_slot = gridDim.x + __hip_atomic_fetch_add(_qc, 1u, __ATOMIC_RELAXED, __HIP_MEMORY_SCOPE_AGENT); __syncthreads(); it = __builtin_amdgcn_readfirstlane((int)*_slot); } } while (0)

__device__ __forceinline__ void phase_mix_a(const Params& p, int l, int g, bool with_ctx, int ph, char* smem) {
  int tid = threadIdx.x; asm volatile("" : "+v"(tid));
  const int n_ha = 480 + (with_ctx ? 64 : 0), n_tb = (with_ctx ? MG : MLAT) / 64;
  QUEUE_LOOP(n_ha + n_tb,
    if (it < n_ha) hgrn_local_item(p, l, it, smem, tid); else tokblock_item(p, l, it - n_ha, smem, tid, true); );
  (void)g;
}
__device__ __forceinline__ void phase_mix_b(const Params& p, int l, int g, bool with_ctx, bool up_ctx, int ph, char* smem) {
  int tid = threadIdx.x; asm volatile("" : "+v"(tid));
  const int n_hc = 256 + (with_ctx ? 32 : 0), n_up = 0, n_na = GB * 8 * 32, n_nc = with_ctx ? NB * 8 * 2 : 0;
  QUEUE_LOOP(n_hc + n_up + n_na + n_nc,
    if (it < n_hc) hgrn_out_item(p, l, g, it, smem, tid);
    else if (it < n_hc + n_up + n_na) { const int q = it - n_hc - n_up; natten_item(p, l, q >> 8, g * GB + (q >> 8), (q >> 5) & 7, q & 31, false, smem, tid); }
    else { const int q = it - n_hc - n_up - n_na; natten_item(p, l, 0, q >> 4, (q >> 1) & 7, q & 1, true, smem, tid); } );
}

constexpr int NPH = 1 + DEPTH * NG * 9;

__global__ __launch_bounds__(512) void mega(Params p_unused) {
  extern __shared__ __attribute__((aligned(16))) char smem[];
  cg::grid_group grid = cg::this_grid();
  LAS unsigned char* lds = (LAS unsigned char*)smem;
  const __attribute__((address_space(4))) Params* kp = (const __attribute__((address_space(4))) Params*)__builtin_amdgcn_kernarg_segment_ptr();
  const int ph_lo = kp->ph_lo, ph_hi = kp->ph_hi;
  volatile LAS unsigned* xbst = (volatile LAS unsigned*)(lds + LDS_BYTES - 16);
  if (threadIdx.x == 0) { xbst[0] = 0u; xbst[1] = 0u; }
  __syncthreads();
  (void)xcd_barrier_post((unsigned*)(kp->ws + OFF_BAR), xbst);
#define MK_XB XcdBarrier xb; xb.bar = (unsigned*)(p.ws + OFF_BAR); xb.x = xb_xcc_id(); xb.st = (volatile LAS unsigned*)(lds + LDS_BYTES - 16)
  for (int ph = ph_lo; ph < ph_hi; ++ph) {
    const __attribute__((address_space(4))) Params* q4 = kp; asm volatile("" : "+s"(q4));
    const Params& p = *(const Params*)q4;
    if (ph == 0) { phase_prologue(p, smem); }
    else {
      const int q = ph - 1, k = q % 9, lg = q / 9, g = lg % NG, l = lg / NG;
      const bool need_ctx = l < DEPTH - 1, cx = need_ctx && g == 1;
      const int bid = bid_(), nb = gridDim.x;
      switch (k) {
        case 0: if (g == 0) { phase_wconv(p, l, smem); phase_norm(p, l, 0, 0, 0, MG, bid, nb); }
                else if (cx) { if (bid < 32) phase_merge(p, MLAT / BM, MCTX / BM, 0, lds); else phase_norm(p, l, 1, 0, 0, MLAT, bid - 32, nb - 32); }
                else phase_norm(p, l, 1, 0, 0, MLAT, bid, nb);
                break;
        case 1: phase_gemm1(p, g == 0 ? MG / BM : MLAT / BM, lds);
                if (cx) phase_gemm_resid(p, l, g, p.ws + OFF_MIX, D, p.ws + OFF_WO, 2, MLAT / BM, MCTX / BM, 128, lds);
                break;
        case 2: phase_mix_a(p, l, g, g == 0, ph, smem); if (cx) phase_norm(p, l, g, 1, MLAT, MG, bid, nb); break;
        case 3: if (cx) phase_up(p, (bf16_t*)(p.ws + OFF_UC) - (size_t)MLAT * DFF, Sched<1>{MCTX / BM, DFF / BM, MLAT / BM, 128}, lds);
                phase_mix_b(p, l, g, g == 0 && need_ctx, cx, ph, smem); break;
        case 4: phase_merge(p, 0, MLAT / BM, 0, lds); if (cx) phase_down_ctx(p, l, lds); break;
        case 5: if (cx) { int t_ = threadIdx.x; asm volatile("" : "+v"(t_)); phase_down_ctx_combine(p, l, bid, t_); }
                phase_gemm_resid(p, l, g, p.ws + OFF_MIX, D, p.ws + OFF_WO, 2, 0, MLAT / BM, 0, lds); break;
        case 6: phase_norm(p, l, g, 1, 0, MLAT, bid, nb); break;
        case 7: phase_up(p, (bf16_t*)(p.ws + OFF_Z), Sched<1>{MLAT / BM, DFF / BM, 0, 0}, lds); break;
        case 8: phase_gemm_resid(p, l, g, p.ws + OFF_Z, DFF, p.ws + OFF_W2, 5, 0, MLAT / BM, 0, lds); break;
      }
    }
    if (ph + 1 < ph_hi) { if (ph == 0) grid.sync(); else { MK_XB; xcd_barrier(xb); } }
  }
}


extern "C" void kernel_launch(void* const* d_in, const int* in_sizes, int n_in, void* d_out, int out_size, void* d_ws, size_t ws_size, hipStream_t stream) {
  static int grid_blocks = 0;
  if (!grid_blocks) {
    int dev = 0, cus = 0, per_cu = 0;
    hipGetDevice(&dev);
    hipDeviceGetAttribute(&cus, hipDeviceAttributeMultiprocessorCount, dev);
    hipFuncSetAttribute((const void*)mega, hipFuncAttributeMaxDynamicSharedMemorySize, LDS_BYTES);
    hipOccupancyMaxActiveBlocksPerMultiprocessor(&per_cu, mega, 512, LDS_BYTES);
    if (per_cu < 1) per_cu = 1;
    grid_blocks = cus;
    if (ws_size < WS_NEED) fprintf(stderr, "workspace too small: %zu < %zu\n", ws_size, (size_t)WS_NEED);
  }
  Params p{};
  const float** f = (const float**)&p;
  for (int i = 0; i < 21; ++i) f[i] = (const float*)d_in[i];
  p.out = (float*)d_out; p.ws = (char*)d_ws; p.ph_lo = 0; p.ph_hi = NPH;
  hipMemsetAsync((char*)d_ws + OFF_BAR, 0, XCD_BAR_BYTES, stream);
  void* args[] = {&p};
  hipError_t e = hipLaunchCooperativeKernel((void*)mega, dim3(grid_blocks), dim3(512), args, LDS_BYTES, stream);
  if (e != hipSuccess) fprintf(stderr, "cooperative launch failed: %s (grid %d)\n", hipGetErrorString(e), grid_blocks);
}
```

```cpp
#include <hip/hip_runtime.h>
#include <hip/hip_cooperative_groups.h>
#include <cstdio>
#include <cstdint>
namespace cg = cooperative_groups;

typedef unsigned short bf16_t;
typedef short bf16x8 __attribute__((ext_vector_type(8)));
typedef float f32x4 __attribute__((ext_vector_type(4)));
typedef unsigned u32x2 __attribute__((ext_vector_type(2)));
typedef unsigned u32x4 __attribute__((ext_vector_type(4)));

constexpr int D = 1024, NB = 8, SEQ = 4096, DEPTH = 4, CTX = 256, PROJ = 8704, DFF = 4096, NMOD = 6;
constexpr int ZLD = 5632;
constexpr int NBLK = 256;
constexpr int GB = 4, NG = NB / GB;
constexpr int MLAT = GB * SEQ, MCTX = NB * CTX, MG = MLAT + MCTX;
constexpr int ZQ = 0, ZFF = 512, ZFB = 1024, ZI = 1536, ZG = 2048, ZNQ = 2560, ZNK = 3072, ZNV = 3584, ZCB = 4096, ZCC = 4608, ZCX = 5120, ZGA = 5632, ZGB = 6656, ZGC = 7680;
constexpr int LDS_BYTES = 140 * 1024, LDS_TOP = LDS_BYTES;
constexpr size_t XCD_BAR_BYTES = 3456 * 4 + 1024;
constexpr int NSC = 16;

constexpr size_t SZ_WIN = (size_t)PROJ * D * 2, SZ_WBR = (size_t)D * 512 * 2, SZ_WO = (size_t)D * D * 2, SZ_W1 = (size_t)DFF * D * 2, SZ_W2 = (size_t)D * DFF * 2;
constexpr size_t OFF_WIN = 0, OFF_WA = OFF_WIN + SZ_WIN, OFF_WB = OFF_WA + SZ_WBR, OFF_WC = OFF_WB + SZ_WBR, OFF_WO = OFF_WC + SZ_WBR, OFF_W1 = OFF_WO + SZ_WO, OFF_W2 = OFF_W1 + SZ_W1;
constexpr size_t OFF_MOD = OFF_W2 + SZ_W2;
constexpr size_t OFF_ROPE = OFF_MOD + (size_t)DEPTH * 9 * NMOD * D * 4;
constexpr size_t OFF_LB = OFF_ROPE + 64 * 16 * 8;
constexpr size_t OFF_HCTX = OFF_LB + 2 * DEPTH * 512 * 4;
constexpr size_t OFF_HN = OFF_HCTX + (size_t)NB * CTX * D * 4;
constexpr size_t OFF_Z = OFF_HN + (size_t)MG * D * 2;
constexpr size_t OFF_GATE = OFF_Z + (size_t)MG * ZLD * 2;
constexpr size_t OFF_Y = OFF_GATE + (size_t)3 * (MG / 256) * 4 * 32 * 512 * 8;
constexpr size_t OFF_MIX = OFF_Y + 3 * (size_t)MG * 512 * 2;
constexpr size_t OFF_VT = OFF_MIX + (size_t)MG * D * 2;
constexpr size_t OFF_VTC = OFF_VT + (size_t)GB * 8 * 64 * SEQ * 2;
constexpr size_t OFF_HD = OFF_VTC + (size_t)NB * 8 * 64 * CTX * 2;
constexpr size_t OFF_LCTX = OFF_HD + (size_t)GB * 4 * 2 * NSC * 128 * 4;
constexpr size_t OFF_HDC = OFF_LCTX + (size_t)NB * 4 * 2 * 16384 * 4;
constexpr size_t OFF_UC = OFF_HDC + (size_t)NB * 4 * 2 * 128 * 4;
constexpr size_t OFF_SLAB = OFF_UC + (size_t)MCTX * DFF * 2;
constexpr size_t OFF_BAR = OFF_SLAB + (size_t)2 * MCTX * D * 4;
constexpr size_t WS_NEED = OFF_BAR + XCD_BAR_BYTES;

struct Params {
  const float *x, *c, *ctx, *c_ctx, *ada_w, *ada_b, *norm1_w, *norm2_w, *w_in, *lb_logits, *onorm_w, *qn_w, *kn_w, *rpb, *conv_w, *w_a, *w_b, *w_c, *w_out, *w1, *w2;
  float* out; char* ws; int ph_lo, ph_hi;
};

typedef float f32x2_ __attribute__((ext_vector_type(2)));
typedef __bf16 bf16x2_ __attribute__((ext_vector_type(2)));
__device__ __forceinline__ unsigned cvt_pk_bf16(float lo, float hi) { const f32x2_ v = {lo, hi}; const bf16x2_ b = __builtin_convertvector(v, bf16x2_); return __builtin_bit_cast(unsigned, b); }
__device__ __forceinline__ bf16_t f2bf(float f) { return (bf16_t)(cvt_pk_bf16(f, 0.f) & 0xffffu); }
__device__ __forceinline__ float bf2f(bf16_t h) { return __uint_as_float(((unsigned)h) << 16); }
__device__ __forceinline__ float bflo(unsigned u) { return __uint_as_float(u << 16); }
__device__ __forceinline__ float bfhi(unsigned u) { return __uint_as_float(u & 0xffff0000u); }
__device__ __forceinline__ float sigmoidf_(float v) { return __builtin_amdgcn_rcpf(1.f + __builtin_amdgcn_exp2f(-1.4426950408889634f * v)); }
__device__ __forceinline__ float siluf_(float v) { return v * __builtin_amdgcn_rcpf(1.f + __builtin_amdgcn_exp2f(-1.4426950408889634f * v)); }

#define LAS __attribute__((address_space(3)))
constexpr int BM = 256, BK = 64, HALF = 128, HTB = HALF * BK * 2, GEMM_LDS = 8 * HTB;
__device__ __forceinline__ int lds_byte(int r, int c) { const int st = (r >> 4) * 2 + (c >> 5), rr = r & 15, cc = c & 31, ob = rr * 64 + cc * 2; return st * 1024 + (ob ^ (((ob >> 9) & 1) << 5)); }
__device__ __forceinline__ void stage_rc(int b, int& R, int& C) { const int st = b / 1024, sb = b % 1024, swz = sb ^ (((sb >> 9) & 1) << 5); R = (st >> 1) * 16 + swz / 64; C = (st & 1) * 32 + (swz % 64) / 2; }

__device__ __forceinline__ int bid_() { int b = blockIdx.x; asm volatile("" : "+s"(b)); return b; }
struct Unit { int pm, pn, br; };
__device__ __forceinline__ void tile_map(int L, int nM, int nN, int& pm, int& pn) {
  const int nwg = nM * nN; int wgid = L;
  { const int q = nwg / 8, r = nwg % 8, xcd = wgid % 8, off = wgid / 8; wgid = (xcd < r ? xcd * (q + 1) : r * (q + 1) + (xcd - r) * q) + off; }
  constexpr int WGM = 4; const int nig = WGM * nN, gid = wgid / nig, fm = gid * WGM, gsz = (nM - fm) < WGM ? (nM - fm) : WGM;
  pm = fm + ((wgid % nig) % gsz); pn = (wgid % nig) / gsz;
}
template <int NBR> struct Sched {
  int nM, nN, pm0, boff;
  __device__ __forceinline__ bool next(int i, Unit& u) const {
    const int c = (bid_() + (int)gridDim.x - boff) % (int)gridDim.x;
    const int L = (i / NBR) * (int)gridDim.x + c; if (L >= nM * nN) return false;
    tile_map(L, nM, nN, u.pm, u.pn); u.pm += pm0; u.br = i % NBR; return true;
  }
};
struct SchedG1 { int nM; bool last;
  __device__ __forceinline__ bool next(int i, Unit& u) const {
    const int L = i * (int)gridDim.x + bid_(); u.br = 0;
    if (!last) { if (L >= nM * (PROJ / 256)) return false; tile_map(L, nM, PROJ / 256, u.pm, u.pn); return true; }
    constexpr int NL = (MLAT / 256) * (PROJ / 256);
    if (L < NL) { tile_map(L, MLAT / 256, PROJ / 256, u.pm, u.pn); return true; }
    const int idx = L - NL; if (idx >= (MCTX / 256) * 10) return false;
    const int t = idx % 10; u.pm = MLAT / 256 + idx / 10; u.pn = t < 6 ? 2 + t : 6 + t; return true;
  }
};
struct SchedOne { int pm, pn; __device__ __forceinline__ bool next(int i, Unit& u) const { if (i) return false; u.pm = pm; u.pn = pn; u.br = 0; return true; } };
struct SchedSplit2 {
  __device__ __forceinline__ bool next(int i, Unit& u) const {
    const int L = i * (int)gridDim.x + bid_(); if (L >= 64) return false;
    const int t = L >> 1; u.pm = MLAT / 256 + (t >> 2); u.pn = t & 3; u.br = L & 1; return true;
  }
};

__device__ __forceinline__ int perm32(int rho) { const int n = rho >> 4, i = rho & 15; return 8 * (i >> 2) + 4 * n + (i & 3); }
template <bool PERM, class S, class FA, class FB, class Epi>
__device__ __forceinline__ void gemm_phase(LAS unsigned char* lds, const int K, const int ld, const S& Sc, const FA& baseA, const FB& baseB, const Epi& E) {
  int tid = threadIdx.x; asm volatile("" : "+v"(tid));
  const int wid = __builtin_amdgcn_readfirstlane(tid >> 6), lane = tid & 63, wr = wid >> 2, wc = wid & 3, fr = lane & 15, fq = lane >> 4;
  const int nt = K / BK;
  unsigned voff[2], voffb[2];
#pragma unroll
  for (int i = 0; i < 2; ++i) { int R, C; stage_rc(tid * 16 + i * 8192, R, C); voff[i] = (unsigned)(R * ld + C) * 2u; const int Rb = PERM ? ((R & ~31) + perm32(R & 31)) : R; voffb[i] = (unsigned)(Rb * ld + C) * 2u; }
  const size_t kstep = (size_t)(BK * 2), hstep = (size_t)HALF * ld * 2, tstep = 2 * hstep;
  const unsigned ldsw = (unsigned)wid * 1024u;
  const int aoff = lds_byte(wr * 64 + fr, fq * 8), boff = lds_byte(wc * 32 + fr, fq * 8);
#define G_SA(b, h) (((b) * 2 + (h)) * HTB)
#define G_SB(b, h) ((4 + (b) * 2 + (h)) * HTB)
#define G_STAGEB(bufoff, gbase) do { _Pragma("unroll") for (int _i = 0; _i < 2; ++_i) \
    __builtin_amdgcn_global_load_lds((const unsigned*)((const char*)(gbase) + voffb[_i]), (LAS unsigned*)(lds + (bufoff) + ldsw + _i * 8192), 16, 0, 0); } while (0)
#define G_STAGE(bufoff, gbase) do { _Pragma("unroll") for (int _i = 0; _i < 2; ++_i) \
    __builtin_amdgcn_global_load_lds((const unsigned*)((const char*)(gbase) + voff[_i]), (LAS unsigned*)(lds + (bufoff) + ldsw + _i * 8192), 16, 0, 0); } while (0)
#define G_LDA(dst, b, h) do { _Pragma("unroll") for (int m = 0; m < 4; ++m) _Pragma("unroll") for (int k = 0; k < 2; ++k) dst[m][k] = *(const LAS bf16x8*)(lds + G_SA(b, h) + aoff + m * 2048 + k * 1024); } while (0)
#define G_LDB(dst, b, h) do { _Pragma("unroll") for (int n = 0; n < 2; ++n) _Pragma("unroll") for (int k = 0; k < 2; ++k) dst[n][k] = *(const LAS bf16x8*)(lds + G_SB(b, h) + boff + n * 2048 + k * 1024); } while (0)
#define G_MMA(ai, bj, At_, Bt_) do { __builtin_amdgcn_s_setprio(1); _Pragma("unroll") for (int m = 0; m < 4; ++m) _Pragma("unroll") for (int n = 0; n < 2; ++n) _Pragma("unroll") for (int k = 0; k < 2; ++k) \
    acc[ai][bj][m][n] = __builtin_amdgcn_mfma_f32_16x16x32_bf16(Bt_[n][k], At_[m][k], acc[ai][bj][m][n], 0, 0, 0); __builtin_amdgcn_s_setprio(0); } while (0)
#define WAIT_V(n) asm volatile("s_waitcnt vmcnt(" #n ")" ::: "memory")
#define WAIT_L(n) asm volatile("s_waitcnt lgkmcnt(" #n ")" ::: "memory")
#define BAR __builtin_amdgcn_s_barrier()
#define SCHED __builtin_amdgcn_sched_barrier(0)
  Unit cur, nxt; int ui = 0;
  if (!Sc.next(0, cur)) return;
  f32x4 acc[2][2][4][2];
#pragma unroll
  for (int a = 0; a < 2; ++a)
#pragma unroll
    for (int b = 0; b < 2; ++b)
#pragma unroll
      for (int m = 0; m < 4; ++m)
#pragma unroll
        for (int n = 0; n < 2; ++n) acc[a][b][m][n] = (f32x4){0.f, 0.f, 0.f, 0.f};
  bf16x8 At[4][2], B0[2][2], B1[2][2];
  const char* cA = baseA(cur) + (size_t)cur.pm * tstep; const char* cB = baseB(cur) + (size_t)cur.pn * tstep;
  G_STAGEB(G_SB(0, 0), cB); G_STAGE(G_SA(0, 0), cA); G_STAGEB(G_SB(0, 1), cB + hstep); G_STAGE(G_SA(0, 1), cA + hstep);
  if (wr == 1) BAR;
  WAIT_V(4); BAR;
  G_STAGEB(G_SB(1, 0), cB + kstep); G_STAGE(G_SA(1, 0), cA + kstep); G_STAGEB(G_SB(1, 1), cB + hstep + kstep);
  WAIT_V(6); BAR;
  for (;;) {
    const bool has_next = Sc.next(ui + 1, nxt);
    const char* nA = has_next ? baseA(nxt) + (size_t)nxt.pm * tstep : cA; const char* nB = has_next ? baseB(nxt) + (size_t)nxt.pn * tstep : cB;
    for (int t = 0; t < nt; t += 2) {
      const bool last = (t == nt - 2);
      const char* a1 = cA + (size_t)(t + 1) * kstep;
      const char* a2 = last ? nA : cA + (size_t)(t + 2) * kstep; const char* b2 = last ? nB : cB + (size_t)(t + 2) * kstep;
      const char* a3 = a2 + kstep; const char* b3 = b2 + kstep;
      G_LDB(B0, 0, 0); SCHED; G_LDA(At, 0, 0); G_STAGE(G_SA(1, 1), a1 + hstep);
      WAIT_L(8); BAR; WAIT_L(0); G_MMA(0, 0, At, B0); BAR; SCHED;
      G_LDB(B1, 0, 1); G_STAGEB(G_SB(0, 0), b2);
      BAR; WAIT_L(0); G_MMA(0, 1, At, B1); BAR;
      G_LDA(At, 0, 1); G_STAGE(G_SA(0, 0), a2);
      BAR; WAIT_L(0); G_MMA(1, 0, At, B0); BAR; SCHED;
      G_STAGEB(G_SB(0, 1), b2 + hstep);
      WAIT_V(6); BAR; G_MMA(1, 1, At, B1); BAR;
      G_LDB(B0, 1, 0); SCHED; G_LDA(At, 1, 0); G_STAGE(G_SA(0, 1), a2 + hstep);
      WAIT_L(8); BAR; WAIT_L(0); G_MMA(0, 0, At, B0); BAR; SCHED;
      G_LDB(B1, 1, 1); G_STAGEB(G_SB(1, 0), b3);
      BAR; WAIT_L(0); G_MMA(0, 1, At, B1); BAR;
      G_LDA(At, 1, 1); G_STAGE(G_SA(1, 0), a3);
      BAR; WAIT_L(0); G_MMA(1, 0, At, B0); BAR; SCHED;
      G_STAGEB(G_SB(1, 1), b3 + hstep);
      WAIT_V(6); BAR; G_MMA(1, 1, At, B1); BAR;
    }
    E(acc, cur, wr, wc, fr, fq);
    if (!has_next) break;
#pragma unroll
    for (int a = 0; a < 2; ++a)
#pragma unroll
      for (int b = 0; b < 2; ++b)
#pragma unroll
        for (int m = 0; m < 4; ++m)
#pragma unroll
          for (int n = 0; n < 2; ++n) acc[a][b][m][n] = (f32x4){0.f, 0.f, 0.f, 0.f};
    cur = nxt; cA = nA; cB = nB; ++ui;
  }
  WAIT_V(0);
  if (wr == 0) BAR;
  BAR;
}

#define EPI_LOOP(...) \
  _Pragma("unroll") for (int ai = 0; ai < 2; ++ai) _Pragma("unroll") for (int m = 0; m < 4; ++m) { const int row = u.pm * BM + ai * HALF + wr * 64 + m * 16 + fr; \
    _Pragma("unroll") for (int bj = 0; bj < 2; ++bj) _Pragma("unroll") for (int n = 0; n < 2; ++n) { const int col = u.pn * BM + bj * HALF + wc * 32 + n * 16 + fq * 4; f32x4 v = acc[ai][bj][m][n]; __VA_ARGS__ } }
#define EPI_SIG (const f32x4 (&acc)[2][2][4][2], const Unit& u, int wr, int wc, int fr, int fq)

__device__ __forceinline__ float* resid_row(const Params& p, int g, int row, int& modr) {
  if (row < MLAT) { const int b = g * GB + (row >> 12); modr = b; return p.out + ((size_t)b * SEQ + (row & 4095)) * D; }
  const int r = row - MLAT; modr = 8; return (float*)(p.ws + OFF_HCTX) + (size_t)r * D;
}


#define XB_TMO      128
#define XB_XCNT(j)  (256  + 64 * (j))
#define XB_XSUB(j)  (1280 + 64 * (j))
#define XB_XGEN(j)  (2304 + 64 * (j))
#define XB_TOP      3328
#define XB_TOPGEN   3392
#define XCD_BAR_WORDS 3456
#define XB_SPIN_CAP (1u << 20)
__device__ __forceinline__ unsigned xb_ld(unsigned* p)              { return __hip_atomic_load(p, __ATOMIC_RELAXED, __HIP_MEMORY_SCOPE_AGENT); }
__device__ __forceinline__ unsigned xb_add(unsigned* p, unsigned v) { return __hip_atomic_fetch_add(p, v, __ATOMIC_RELAXED, __HIP_MEMORY_SCOPE_AGENT); }
__device__ __forceinline__ unsigned xb_xcc_id() { return (unsigned)__builtin_amdgcn_s_getreg((3 << 11) | 20) & 0xFu; }
#define XB_SPIN(cond, bar) do { unsigned _sp = 0; while (cond) { __builtin_amdgcn_s_sleep(1); \
    if ((++_sp & 255u) == 0u) { if (xb_ld(&(bar)[XB_TMO])) break; if (_sp > XB_SPIN_CAP) { atomicAdd(&(bar)[XB_TMO], 1u); break; } } } } while (0)
struct XcdBarrier { unsigned* bar; unsigned x; volatile LAS unsigned* st; };
__device__ __forceinline__ XcdBarrier xcd_barrier_post(unsigned* bar, volatile LAS unsigned* st) {
  XcdBarrier b; b.bar = bar; b.x = xb_xcc_id(); b.st = st;
  if (threadIdx.x == 0) (void)xb_add(&bar[XB_XCNT(b.x)], 1u);
  return b;
}
__device__ __forceinline__ void xcd_barrier_complete(unsigned* bar, unsigned x, unsigned& nloc, unsigned& nx) {
  const unsigned G = gridDim.x * gridDim.y * gridDim.z;
  unsigned sum, cnt, mine, sp = 0u;
  for (;;) {
    sum = 0u; cnt = 0u; mine = 0u;
#pragma unroll
    for (unsigned j = 0; j < 16; ++j) { const unsigned c = xb_ld(&bar[XB_XCNT(j)]); sum += c; cnt += (c > 0u) ? 1u : 0u; mine = (j == x) ? c : mine; }
    if (sum == G) break;
    __builtin_amdgcn_s_sleep(1);
    if ((++sp & 255u) == 0u) { if (xb_ld(&bar[XB_TMO])) break; if (sp > XB_SPIN_CAP) { atomicAdd(&bar[XB_TMO], 1u); break; } }
  }
  nloc = mine > 0u ? mine : 1u; nx = cnt > 0u ? cnt : 1u;
}
__device__ __forceinline__ void xcd_barrier(const XcdBarrier& b) {
  asm volatile("s_waitcnt vmcnt(0)" ::: "memory");
  __syncthreads();
  if (threadIdx.x == 0) {
    unsigned* bar = b.bar;
    __builtin_amdgcn_s_waitcnt(0);
    unsigned nloc = b.st[0], nx = b.st[1];
    if (nloc == 0u) { xcd_barrier_complete(bar, b.x, nloc, nx); b.st[0] = nloc; b.st[1] = nx; }
    const unsigned old = xb_add(&bar[XB_XSUB(b.x)], 1u);
    const unsigned gen = old / nloc;
    if (old + 1u == (gen + 1u) * nloc) {
      __builtin_amdgcn_fence(__ATOMIC_RELEASE, "agent");
      asm volatile("s_waitcnt vmcnt(0)" ::: "memory");
      const unsigned og = xb_add(&bar[XB_TOP], 1u);
      const unsigned tg = og / nx;
      if (og + 1u == (tg + 1u) * nx) xb_add(&bar[XB_TOPGEN], 1u);
      else XB_SPIN(xb_ld(&bar[XB_TOPGEN]) == tg, bar);
      __builtin_amdgcn_fence(__ATOMIC_ACQUIRE, "agent");
      xb_add(&bar[XB_XGEN(b.x)], 1u);
      asm volatile("s_waitcnt vmcnt(0)" ::: "memory");
    } else {
      XB_SPIN(xb_ld(&bar[XB_XGEN(b.x)]) == gen, bar);
      __builtin_amdgcn_fence(__ATOMIC_ACQUIRE, "agent");
      asm volatile("s_waitcnt vmcnt(0)" ::: "memory");
    }
  }
  __syncthreads();
}

__device__ void phase_prologue(const Params& p, char* smem) {
  int tid = threadIdx.x; asm volatile("" : "+v"(tid));
  float* mod = (float*)(p.ws + OFF_MOD);
  float* sc = (float*)smem;
  float* red = sc + 9 * 1024;
  for (int i = tid; i < 9 * 1024; i += 512) { const int r = i >> 10, k = i & 1023; const float v = r < 8 ? p.c[r * 1024 + k] : p.c_ctx[k]; sc[i] = siluf_(v); }
  __syncthreads();
  for (int it = blockIdx.x; it < DEPTH * NMOD * D / 128; it += gridDim.x) {
    const int l = it / (NMOD * D / 128), n0 = (it % (NMOD * D / 128)) * 128, c = tid & 127, ks = tid >> 7;
    const float* w = p.ada_w + (size_t)l * D * (NMOD * D) + n0 + c;
    float a[9];
#pragma unroll
    for (int r = 0; r < 9; ++r) a[r] = 0.f;
    for (int k = ks * 256; k < ks * 256 + 256; ++k) { const float wv = w[(size_t)k * (NMOD * D)];
#pragma unroll
      for (int r = 0; r < 9; ++r) a[r] += sc[r * 1024 + k] * wv; }
#pragma unroll
    for (int r = 0; r < 9; ++r) red[(ks * 9 + r) * 128 + c] = a[r];
    __syncthreads();
    for (int i = tid; i < 9 * 128; i += 512) { const int r = i >> 7, cc = i & 127;
      mod[((size_t)l * 9 + r) * (NMOD * D) + n0 + cc] = red[(0 * 9 + r) * 128 + cc] + red[(1 * 9 + r) * 128 + cc] + red[(2 * 9 + r) * 128 + cc] + red[(3 * 9 + r) * 128 + cc] + p.ada_b[l * NMOD * D + n0 + cc]; }
    __syncthreads();
  }
  const size_t gt = (size_t)blockIdx.x * 512 + tid, gn = (size_t)gridDim.x * 512;
  if (gt < 1024) {
    const int pos = (int)gt >> 4, i = (int)gt & 15; const float inv = exp2f(-(float)i * (13.287712379549449f / 16.f)), ang = (float)pos * inv;
    float s, c; s = sinf(ang); c = cosf(ang);
    ((float2*)(p.ws + OFF_ROPE))[gt] = make_float2(c, s);
  }
  if (gt < 2 * 512) {
    const int dir = (int)gt >> 9, k = (int)gt & 511; float lg[DEPTH], mx = -1e30f, sum = 0.f;
#pragma unroll
    for (int l = 0; l < DEPTH; ++l) { lg[l] = p.lb_logits[((size_t)dir * DEPTH + l) * 512 + k]; mx = fmaxf(mx, lg[l]); }
#pragma unroll
    for (int l = 0; l < DEPTH; ++l) { lg[l] = __expf(lg[l] - mx); sum += lg[l]; }
    float cum = 0.f; float* lb = (float*)(p.ws + OFF_LB);
#pragma unroll
    for (int l = 0; l < DEPTH; ++l) { if (l > 0) cum += lg[l] / sum; lb[((size_t)dir * DEPTH + l) * 512 + k] = cum; }
  }
  { const float4* s = (const float4*)p.ctx; float4* d = (float4*)(p.ws + OFF_HCTX); const size_t n = (size_t)NB * CTX * D / 4; for (size_t i = gt; i < n; i += gn) d[i] = s[i]; }
}

__device__ void wconv_tiles(const float* __restrict__ W, bf16_t* __restrict__ Wt, int K, int N, int item0, int& item_base, char* smem) {
  float* tile = (float*)smem;
  int tid = threadIdx.x; asm volatile("" : "+v"(tid));
  const int tk = K / 64, tn = N / 64, nt = tk * tn;
  int first = item_base; item_base += nt;
  int start = (bid_() - (first % (int)gridDim.x) + (int)gridDim.x) % (int)gridDim.x;
  const int tx = tid & 63, ty = tid >> 6, gstep = (int)gridDim.x;
  float cur[8];
  if (start < nt) { const int k0 = (start / tn) * 64, n0 = (start % tn) * 64;
#pragma unroll
    for (int i = 0; i < 8; ++i) cur[i] = W[(size_t)(k0 + ty * 8 + i) * N + n0 + tx]; }
  for (int t = start; t < nt; t += gstep) {
    const int k0 = (t / tn) * 64, n0 = (t % tn) * 64;
#pragma unroll
    for (int i = 0; i < 8; ++i) tile[(ty * 8 + i) * 65 + tx] = cur[i];
    if (t + gstep < nt) { const int k1 = ((t + gstep) / tn) * 64, n1 = ((t + gstep) % tn) * 64;
#pragma unroll
      for (int i = 0; i < 8; ++i) cur[i] = W[(size_t)(k1 + ty * 8 + i) * N + n1 + tx]; }
    __syncthreads();
    { const int kp = tid & 31, ng = tid >> 5;
#pragma unroll
      for (int i = 0; i < 4; ++i) { const int n = ng * 4 + i; *(unsigned*)(Wt + (size_t)(n0 + n) * K + k0 + kp * 2) = cvt_pk_bf16(tile[(kp * 2) * 65 + n], tile[(kp * 2 + 1) * 65 + n]); } }
    __syncthreads();
  }
  (void)item0;
}

__device__ void phase_wconv(const Params& p, int l, char* smem) {
  int base = 0;
  wconv_tiles(p.w_in + (size_t)l * D * PROJ, (bf16_t*)(p.ws + OFF_WIN), D, PROJ, 0, base, smem);
  wconv_tiles(p.w_a + (size_t)l * 512 * D, (bf16_t*)(p.ws + OFF_WA), 512, D, 0, base, smem);
  wconv_tiles(p.w_b + (size_t)l * 512 * D, (bf16_t*)(p.ws + OFF_WB), 512, D, 0, base, smem);
  wconv_tiles(p.w_c + (size_t)l * 512 * D, (bf16_t*)(p.ws + OFF_WC), 512, D, 0, base, smem);
  wconv_tiles(p.w_out + (size_t)l * D * D, (bf16_t*)(p.ws + OFF_WO), D, D, 0, base, smem);
  wconv_tiles(p.w1 + (size_t)l * D * DFF, (bf16_t*)(p.ws + OFF_W1), D, DFF, 0, base, smem);
  wconv_tiles(p.w2 + (size_t)l * DFF * D, (bf16_t*)(p.ws + OFF_W2), DFF, D, 0, base, smem);
}

__device__ void phase_norm(const Params& p, int l, int g, int which, int row_lo, int row_hi, int bid, int nb) {
  int tid = threadIdx.x; asm volatile("" : "+v"(tid));
  const int wave = tid >> 6, lane = tid & 63;
  const float* nw = (which ? p.norm2_w : p.norm1_w) + l * D;
  const float* mod = (const float*)(p.ws + OFF_MOD) + (size_t)l * 9 * NMOD * D;
  bf16_t* hn = (bf16_t*)(p.ws + OFF_HN);
  float4 vn[4]; int row = row_lo + bid * 8 + wave;
  auto src = [&](int r) -> const float* { int mr; const float* xr = resid_row(p, g, r, mr); if (l == 0 && which == 0 && r < MLAT) xr = p.x + (xr - p.out); return xr; };
  if (row < row_hi) { const float* xr = src(row);
#pragma unroll
    for (int j = 0; j < 4; ++j) vn[j] = *(const float4*)(xr + j * 256 + lane * 4); }
  for (; row < row_hi; row += nb * 8) {
    int modr; (void)resid_row(p, g, row, modr);
    const float* sh = mod + (size_t)modr * NMOD * D + (which ? 3 : 0) * D; const float* scl = sh + D;
    float4 v[4]; float ss = 0.f;
#pragma unroll
    for (int j = 0; j < 4; ++j) v[j] = vn[j];
    if (row + nb * 8 < row_hi) { const float* xr = src(row + nb * 8);
#pragma unroll
      for (int j = 0; j < 4; ++j) vn[j] = *(const float4*)(xr + j * 256 + lane * 4); }
    float4 w4[4], s14[4], s04[4];
#pragma unroll
    for (int j = 0; j < 4; ++j) { const int c = j * 256 + lane * 4; w4[j] = *(const float4*)(nw + c); s14[j] = *(const float4*)(scl + c); s04[j] = *(const float4*)(sh + c); }
#pragma unroll
    for (int j = 0; j < 4; ++j) ss += v[j].x * v[j].x + v[j].y * v[j].y + v[j].z * v[j].z + v[j].w * v[j].w;
#pragma unroll
    for (int o = 32; o > 0; o >>= 1) ss += __shfl_xor(ss, o);
    const float rstd = rsqrtf(ss * (1.f / D) + 1e-6f);
#pragma unroll
    for (int j = 0; j < 4; ++j) { const int c = j * 256 + lane * 4; const float4 w = w4[j], s1 = s14[j], s0 = s04[j];
      u32x2 o; o.x = cvt_pk_bf16(v[j].x * rstd * w.x * (1.f + s1.x) + s0.x, v[j].y * rstd * w.y * (1.f + s1.y) + s0.y);
      o.y = cvt_pk_bf16(v[j].z * rstd * w.z * (1.f + s1.z) + s0.z, v[j].w * rstd * w.w * (1.f + s1.w) + s0.w);
      *(u32x2*)(hn + (size_t)row * D + c) = o; }
  }
}

__device__ __forceinline__ void phase_gemm1(const Params& p, int nM, bool last_ctx, LAS unsigned char* lds) {
  const char* A = p.ws + OFF_HN; const char* Bt = p.ws + OFF_WIN; bf16_t* z = (bf16_t*)(p.ws + OFF_Z); u32x2* gates = (u32x2*)(p.ws + OFF_GATE);
  SchedG1 sc{nM, last_ctx};
  gemm_phase<true>(lds, D, D, sc, [=](const Unit&) { return A; }, [=](const Unit&) { return Bt; },
    [=] EPI_SIG { const int seg = u.pn >> 1;
      if (seg >= 11) {
        const int gp_ = u.pn - 22; u32x2* gt = gates + ((size_t)((gp_ >> 2) * (MG / 256) + u.pm) * 4 + (gp_ & 3)) * 32 * 512 + ((wr * 4 + wc) * 64 + fr) + (fq >> 1) * 512 + (fq & 1) * 32; asm volatile("" : "+v"(gt));
#pragma unroll
        for (int ai = 0; ai < 2; ++ai)
#pragma unroll
          for (int m = 0; m < 4; ++m)
#pragma unroll
            for (int bj = 0; bj < 2; ++bj)
#pragma unroll
              for (int n = 0; n < 2; ++n) { const f32x4 v = acc[ai][bj][m][n]; u32x2 o; o.x = cvt_pk_bf16(sigmoidf_(v[0]), sigmoidf_(v[1])); o.y = cvt_pk_bf16(sigmoidf_(v[2]), sigmoidf_(v[3]));
                gt[(ai * 16 + m * 4 + bj * 2) * 512 + n * 16] = o; }
      } else {
      EPI_LOOP(
        if (seg == 0 || seg == 4) { v[0] = siluf_(v[0]); v[1] = siluf_(v[1]); v[2] = siluf_(v[2]); v[3] = siluf_(v[3]); }
        u32x2 o; o.x = cvt_pk_bf16(v[0], v[1]); o.y = cvt_pk_bf16(v[2], v[3]);
        *(u32x2*)(z + (size_t)row * ZLD + (col - n * 16 - fq * 4 + fq * 8 + n * 4)) = o; ) } });
}

__device__ __forceinline__ void phase_merge(const Params& p, int pm0, int nM, int boff, LAS unsigned char* lds) {
  const u32x2* gates = (const u32x2*)(p.ws + OFF_GATE); bf16_t* mix = (bf16_t*)(p.ws + OFF_MIX);
  const char* Y = p.ws + OFF_Y; const char* W = p.ws + OFF_WA;
  Sched<3> sc{nM, D / BM, pm0, boff};
  gemm_phase<false>(lds, 512, 512, sc, [=](const Unit& u) { return Y + (size_t)u.br * MG * 512 * 2; }, [=](const Unit& u) { return W + (size_t)u.br * SZ_WBR; },
    [=] EPI_SIG { const int br = u.br; const u32x2* gtp = gates + ((size_t)(br * (MG / 256) + u.pm) * 4 + u.pn) * 32 * 512 + ((wr * 4 + wc) * 64 + fq * 16 + fr);
      u32x2 gt[2][4][2][2];
#pragma unroll
      for (int ai = 0; ai < 2; ++ai)
#pragma unroll
        for (int m = 0; m < 4; ++m)
#pragma unroll
          for (int bj = 0; bj < 2; ++bj)
#pragma unroll
            for (int n = 0; n < 2; ++n) gt[ai][m][bj][n] = gtp[(size_t)(ai * 16 + m * 4 + bj * 2 + n) * 512];
#pragma unroll
      for (int ai = 0; ai < 2; ++ai) {
        u32x2 pv[4][2][2];
#pragma unroll
        for (int m = 0; m < 4; ++m) { const int row = u.pm * BM + ai * HALF + wr * 64 + m * 16 + fr;
#pragma unroll
          for (int bj = 0; bj < 2; ++bj)
#pragma unroll
            for (int n = 0; n < 2; ++n) { const int col = u.pn * BM + bj * HALF + wc * 32 + n * 16 + fq * 4;
              if (br > 0) pv[m][bj][n] = __builtin_nontemporal_load((const u32x2*)(mix + (size_t)row * D + col)); else pv[m][bj][n] = (u32x2){0u, 0u}; } }
        asm volatile("" ::: "memory");
#pragma unroll
        for (int m = 0; m < 4; ++m) { const int row = u.pm * BM + ai * HALF + wr * 64 + m * 16 + fr;
#pragma unroll
          for (int bj = 0; bj < 2; ++bj)
#pragma unroll
            for (int n = 0; n < 2; ++n) { const int col = u.pn * BM + bj * HALF + wc * 32 + n * 16 + fq * 4; const f32x4 v = acc[ai][bj][m][n]; const u32x2 g2 = gt[ai][m][bj][n], p2 = pv[m][bj][n];
              u32x2 o; o.x = cvt_pk_bf16(bflo(g2.x) * v[0] + bflo(p2.x), bfhi(g2.x) * v[1] + bfhi(p2.x)); o.y = cvt_pk_bf16(bflo(g2.y) * v[2] + bflo(p2.y), bfhi(g2.y) * v[3] + bfhi(p2.y));
              *(u32x2*)(mix + (size_t)row * D + col) = o; } }
        asm volatile("" ::: "memory");
      } });
}

__device__ __forceinline__ void phase_gemm_resid(const Params& p, int l, int g, const char* A, int K, const char* Bt, int chunk, int pm0, int nM, int boff, LAS unsigned char* lds) {
  const float* mod = (const float*)(p.ws + OFF_MOD) + (size_t)l * 9 * NMOD * D + chunk * D;
  float* out = p.out; float* hctx = (float*)(p.ws + OFF_HCTX); const float* xin = p.x; const bool first = (l == 0 && chunk == 2);
  Sched<1> sc{nM, D / BM, pm0, boff};
  gemm_phase<false>(lds, K, K, sc, [=](const Unit&) { return A; }, [=](const Unit&) { return Bt; },
    [=] EPI_SIG {
      const int row0 = u.pm * BM + wr * 64 + fr; const bool lat = row0 < MLAT; const int modr = lat ? g * GB + (row0 >> 12) : 8;
      float* xb0 = lat ? out + ((size_t)modr * SEQ + (row0 & 4095)) * D : hctx + (size_t)(row0 - MLAT) * D;
      const float* xs0 = (first && lat) ? xin + (xb0 - out) : xb0;
      const int col0 = u.pn * BM + wc * 32 + fq * 4;
      f32x4 mv[2][2];
#pragma unroll
      for (int bj = 0; bj < 2; ++bj)
#pragma unroll
        for (int n = 0; n < 2; ++n) mv[bj][n] = *(const f32x4*)(mod + (size_t)modr * NMOD * D + col0 + bj * HALF + n * 16);
#pragma unroll
      for (int ai = 0; ai < 2; ++ai) {
        f32x4 xv[4][2][2];
#pragma unroll
        for (int m = 0; m < 4; ++m)
#pragma unroll
          for (int bj = 0; bj < 2; ++bj)
#pragma unroll
            for (int n = 0; n < 2; ++n) xv[m][bj][n] = *(const f32x4*)(xs0 + (size_t)(ai * HALF + m * 16) * D + col0 + bj * HALF + n * 16);
        asm volatile("" ::: "memory");
#pragma unroll
        for (int m = 0; m < 4; ++m)
#pragma unroll
          for (int bj = 0; bj < 2; ++bj)
#pragma unroll
            for (int n = 0; n < 2; ++n) *(f32x4*)(xb0 + (size_t)(ai * HALF + m * 16) * D + col0 + bj * HALF + n * 16) = xv[m][bj][n] + mv[bj][n] * acc[ai][bj][m][n];
        asm volatile("" ::: "memory");
      } });
}

__device__ __forceinline__ void phase_down_ctx(const Params& p, int l, LAS unsigned char* lds) {
  float* slab = (float*)(p.ws + OFF_SLAB);
  const char* A = p.ws + OFF_UC - (size_t)MLAT * DFF * 2; const char* Bt = p.ws + OFF_W2;
  SchedSplit2 sc;
  gemm_phase<false>(lds, 2048, DFF, sc, [=](const Unit& u) { return A + (size_t)u.br * 4096; }, [=](const Unit& u) { return Bt + (size_t)u.br * 4096; },
    [=] EPI_SIG { float* sl = slab + (size_t)u.br * MCTX * D;
      EPI_LOOP( *(f32x4*)(sl + (size_t)(row - MLAT) * D + col) = v; ) });
  (void)l;
}
__device__ __forceinline__ void phase_down_ctx_combine(const Params& p, int l, int bid, int tid) {
  const float* mod = (const float*)(p.ws + OFF_MOD) + ((size_t)l * 9 + 8) * NMOD * D + 5 * D;
  const f32x4* s0 = (const f32x4*)(p.ws + OFF_SLAB); const f32x4* s1 = s0 + (size_t)MCTX * D / 4; f32x4* hc = (f32x4*)(p.ws + OFF_HCTX);
  for (int i = bid * 512 + tid; i < MCTX * D / 4; i += (int)gridDim.x * 512) { const f32x4 mv = *(const f32x4*)(mod + (i & 255) * 4); hc[i] += mv * (s0[i] + s1[i]); }
}

template <class SC>
__device__ __forceinline__ void phase_up(const Params& p, bf16_t* uo, const SC& sc, LAS unsigned char* lds) {
  const char* A = p.ws + OFF_HN; const char* Bt = p.ws + OFF_W1;
  gemm_phase<true>(lds, D, D, sc, [=](const Unit&) { return A; }, [=](const Unit&) { return Bt; },
    [=] EPI_SIG {
      EPI_LOOP(
        float r0 = fmaxf(v[0], 0.f); float r1 = fmaxf(v[1], 0.f); float r2 = fmaxf(v[2], 0.f); float r3 = fmaxf(v[3], 0.f);
        u32x2 o; o.x = cvt_pk_bf16(r0 * r0, r1 * r1); o.y = cvt_pk_bf16(r2 * r2, r3 * r3);
        *(u32x2*)(uo + (size_t)row * DFF + (col - n * 16 - fq * 4 + fq * 8 + n * 4)) = o; ) });
}

__device__ __forceinline__ bf16x8 lds_frag(const char* base, int row, int pitch_b, int colb) { return *(const bf16x8*)(base + row * pitch_b + colb); }

__device__ __forceinline__ void tokblock_item(const Params& p, int l, int it, char* smem, int tid, bool do_prep) {
  bf16_t* z = (bf16_t*)(p.ws + OFF_Z);
  const int row0 = it * 64, wave = tid >> 6, lane = tid & 63;
  const bool is_ctx = row0 >= MLAT;
  if (do_prep) {
    const float2* rope = (const float2*)(p.ws + OFF_ROPE);
    const int s = lane & 7, ax = s >> 2, hf = (s >> 1) & 1;
    float qw[8], kw[8];
#pragma unroll
    for (int j = 0; j < 8; ++j) { qw[j] = p.qn_w[l * 64 + s * 8 + j]; kw[j] = p.kn_w[l * 64 + s * 8 + j]; }
    u32x4 rawqk[8][2];
#pragma unroll
    for (int tt = 0; tt < 8; ++tt)
#pragma unroll
      for (int which = 0; which < 2; ++which) rawqk[tt][which] = *(const u32x4*)(z + (size_t)(row0 + wave * 8 + tt) * ZLD + (which ? ZNK : ZNQ) + lane * 8);
#pragma unroll
    for (int tt = 0; tt < 8; ++tt) {
      const int row = row0 + wave * 8 + tt, t = row & 4095, pos = ax ? (t & 63) : (t >> 6);
#pragma unroll
      for (int which = 0; which < 2; ++which) {
        bf16_t* ptr = z + (size_t)row * ZLD + (which ? ZNK : ZNQ) + lane * 8;
        const u32x4 raw = rawqk[tt][which];
        float y[8] = {bflo(raw.x), bfhi(raw.x), bflo(raw.y), bfhi(raw.y), bflo(raw.z), bfhi(raw.z), bflo(raw.w), bfhi(raw.w)};
        float ss = 0.f;
#pragma unroll
        for (int j = 0; j < 8; ++j) ss += y[j] * y[j];
        ss += __shfl_xor(ss, 1); ss += __shfl_xor(ss, 2); ss += __shfl_xor(ss, 4);
        const float rstd = rsqrtf(ss * (1.f / 64.f) + 1e-6f) ;
#pragma unroll
        for (int j = 0; j < 8; ++j) y[j] = y[j] * rstd * (which ? kw[j] : qw[j]);
        if (!is_ctx) {
#pragma unroll
          for (int j = 0; j < 8; ++j) { const float yp = __shfl_xor(y[j], 2); const float2 cs = rope[pos * 16 + (s & 1) * 8 + j]; y[j] = y[j] * cs.x + (hf ? yp : -yp) * cs.y; }
        }
        if (which == 0) {
#pragma unroll
          for (int j = 0; j < 8; ++j) y[j] *= 0.18033688011112042f;
        }
        u32x4 o; o.x = cvt_pk_bf16(y[0], y[1]); o.y = cvt_pk_bf16(y[2], y[3]); o.z = cvt_pk_bf16(y[4], y[5]); o.w = cvt_pk_bf16(y[6], y[7]);
        *(u32x4*)ptr = o;
      }
    }
  }
  {
    bf16_t* Vl = (bf16_t*)smem;
    { u32x4 tv[8];
#pragma unroll
      for (int i = 0; i < 8; ++i) { const int q = tid + i * 512, tok = q >> 6, cg = q & 63; tv[i] = *(const u32x4*)(z + (size_t)(row0 + tok) * ZLD + ZNV + cg * 8); }
#pragma unroll
      for (int i = 0; i < 8; ++i) { const int q = tid + i * 512, tok = q >> 6, cg = q & 63; *(u32x4*)(Vl + tok * 520 + cg * 8) = tv[i]; } }
    __syncthreads();
    const int bl = is_ctx ? ((row0 - MLAT) >> 8) : (row0 >> 12), TOKS = is_ctx ? CTX : SEQ;
    const int tokpos = is_ctx ? ((row0 - MLAT) & 255) : (row0 & 4095);
    bf16_t* vt = (bf16_t*)(p.ws + (is_ctx ? OFF_VTC : OFF_VT)) + (size_t)bl * 512 * TOKS + tokpos;
#pragma unroll
    for (int i = 0; i < 8; ++i) { const int q = tid + i * 512, tg = q & 7, c = q >> 3;
      unsigned short e[8];
#pragma unroll
      for (int j = 0; j < 8; ++j) e[j] = Vl[(tg * 8 + j) * 520 + c];
      u32x4 o; o.x = e[0] | ((unsigned)e[1] << 16); o.y = e[2] | ((unsigned)e[3] << 16); o.z = e[4] | ((unsigned)e[5] << 16); o.w = e[6] | ((unsigned)e[7] << 16);
      *(u32x4*)(vt + (size_t)c * TOKS + tg * 8) = o; }
    __syncthreads();
  }
  {
    bf16_t* yc = (bf16_t*)(p.ws + OFF_Y) + (size_t)2 * MG * 512;
    const float* cw = p.conv_w + (size_t)l * 3 * 512;
#pragma unroll 4
    for (int i = 0; i < 8; ++i) { const int q = tid + i * 512, cg = q & 63, row = row0 + (q >> 6);
      const int pos = is_ctx ? ((row - MLAT) & 255) : (row & 4095), len = is_ctx ? CTX : SEQ;
      const bf16_t* zr = z + (size_t)row * ZLD + cg * 8;
      const u32x4 bb = *(const u32x4*)(zr + ZCB);
      u32x4 cc[3], xx[3];
#pragma unroll
      for (int d = 0; d < 3; ++d) { const bool ok = (d == 1) || (d == 0 ? pos > 0 : pos < len - 1);
        if (ok) { cc[d] = *(const u32x4*)(zr + (ptrdiff_t)(d - 1) * ZLD + ZCC); xx[d] = *(const u32x4*)(zr + (ptrdiff_t)(d - 1) * ZLD + ZCX); }
        else { cc[d] = (u32x4){0, 0, 0, 0}; xx[d] = (u32x4){0, 0, 0, 0}; } }
      float r[8];
#pragma unroll
      for (int j = 0; j < 8; ++j) { const int ch = cg * 8 + j; float acc = 0.f;
#pragma unroll
        for (int d = 0; d < 3; ++d) { const unsigned cu = cc[d][j >> 1], xu = xx[d][j >> 1]; const float cv = (j & 1) ? bfhi(cu) : bflo(cu), xv = (j & 1) ? bfhi(xu) : bflo(xu); acc += cw[d * 512 + ch] * (cv * xv); }
        const unsigned bu = bb[j >> 1]; r[j] = ((j & 1) ? bfhi(bu) : bflo(bu)) * acc; }
      u32x4 o; o.x = cvt_pk_bf16(r[0], r[1]); o.y = cvt_pk_bf16(r[2], r[3]); o.z = cvt_pk_bf16(r[4], r[5]); o.w = cvt_pk_bf16(r[6], r[7]);
      *(u32x4*)(yc + (size_t)row * 512 + cg * 8) = o; }
  }
}

constexpr int H_QS = 0, H_QI = 17408, H_KS = 34816, H_KHT = 52224, H_VTL = 70656, H_ST = 89088, H_PL = 123904, H_PSUM = 133120, H_DC = 137216;
constexpr int P136 = 272, P72 = 144;

struct HRaw { unsigned f[8], v[8], q[8]; };
template <bool FULL>
__device__ __forceinline__ void hgrn_load(HRaw& r, const bf16_t* __restrict__ z, int h, int dir, int rowbase, int c, int tid) {
  const int kp = tid & 63, part = tid >> 6, k0 = 2 * kp;
#pragma unroll
  for (int e = 0; e < 8; ++e) { const int tau = c * 64 + part * 8 + e, row = rowbase + (dir ? 255 - tau : tau);
    const bf16_t* zr = z + (size_t)row * ZLD + h * 128 + k0;
    r.f[e] = *(const unsigned*)(zr + (dir ? ZFB : ZFF)); r.v[e] = *(const unsigned*)(zr + ZI);
    if (FULL) r.q[e] = *(const unsigned*)(zr + ZQ); }
}
template <bool FULL>
__device__ __forceinline__ float2 hgrn_prep(const HRaw& r, const float* __restrict__ lbv, int h, char* smem, int tid) {
  const int kp = tid & 63, part = tid >> 6, k0 = 2 * kp;
  const float lb0 = lbv[h * 128 + k0], lb1 = lbv[h * 128 + k0 + 1];
  float lg0[8], lg1[8], kk0[8], kk1[8]; unsigned qr[8], vr[8];
  float s0 = 0.f, s1 = 0.f;
#pragma unroll
  for (int e = 0; e < 8; ++e) {
    const unsigned fr_ = r.f[e]; vr[e] = r.v[e];
    if (FULL) qr[e] = r.q[e];
    const float g0 = lb0 + (1.f - lb0) * sigmoidf_(bflo(fr_)), g1 = lb1 + (1.f - lb1) * sigmoidf_(bfhi(fr_));
    lg0[e] = __logf(g0); lg1[e] = __logf(g1); kk0[e] = 1.f - g0; kk1[e] = 1.f - g1; s0 += lg0[e]; s1 += lg1[e]; }
  float* psum = (float*)(smem + H_PSUM);
  psum[part * 128 + k0] = s0; psum[part * 128 + k0 + 1] = s1;
  __syncthreads();
  float pre0 = 0.f, pre1 = 0.f, tot0 = 0.f, tot1 = 0.f, gm0 = 0.f, gm1 = 0.f;
#pragma unroll
  for (int pp = 0; pp < 8; ++pp) { const float a = psum[pp * 128 + k0], b = psum[pp * 128 + k0 + 1]; tot0 += a; tot1 += b; if (pp < part) { pre0 += a; pre1 += b; } if (pp < 4) { gm0 += a; gm1 += b; } }
  unsigned kh0[4], kh1[4], v0[4], v1[4]; float pk0 = 0.f, pk1 = 0.f; unsigned pv0 = 0, pv1 = 0;
  float G0 = pre0, G1 = pre1;
#pragma unroll
  for (int e = 0; e < 8; ++e) { G0 += lg0[e]; G1 += lg1[e]; const int tau = part * 8 + e;
    if (FULL) {
      const float q0 = bflo(qr[e]), q1 = bfhi(qr[e]);
      *(unsigned*)(smem + H_QS + tau * P136 + k0 * 2) = cvt_pk_bf16(q0 * __expf(fminf(G0 - gm0, 80.f)), q1 * __expf(fminf(G1 - gm1, 80.f)));
      *(unsigned*)(smem + H_QI + tau * P136 + k0 * 2) = cvt_pk_bf16(q0 * __expf(G0), q1 * __expf(G1));
      *(unsigned*)(smem + H_KS + tau * P136 + k0 * 2) = cvt_pk_bf16(kk0[e] * __expf(fminf(gm0 - G0, 80.f)), kk1[e] * __expf(fminf(gm1 - G1, 80.f)));
    }
    const float a0 = kk0[e] * __expf(tot0 - G0), a1 = kk1[e] * __expf(tot1 - G1);
    if (e & 1) { kh0[e >> 1] = cvt_pk_bf16(pk0, a0); kh1[e >> 1] = cvt_pk_bf16(pk1, a1); v0[e >> 1] = (pv0 & 0xffffu) | (vr[e] << 16); v1[e >> 1] = (pv1 >> 16) | (vr[e] & 0xffff0000u); }
    else { pk0 = a0; pk1 = a1; pv0 = vr[e]; pv1 = vr[e]; } }
  *(u32x4*)(smem + H_KHT + k0 * P72 + part * 16) = (u32x4){kh0[0], kh0[1], kh0[2], kh0[3]};
  *(u32x4*)(smem + H_KHT + (k0 + 1) * P72 + part * 16) = (u32x4){kh1[0], kh1[1], kh1[2], kh1[3]};
  *(u32x4*)(smem + H_VTL + k0 * P72 + part * 16) = (u32x4){v0[0], v0[1], v0[2], v0[3]};
  *(u32x4*)(smem + H_VTL + (k0 + 1) * P72 + part * 16) = (u32x4){v1[0], v1[1], v1[2], v1[3]};
  if (part == 0) { float* dc = (float*)(smem + H_DC); dc[k0] = __expf(tot0); dc[k0 + 1] = __expf(tot1); }
  return make_float2(tot0, tot1);
}

__device__ __forceinline__ void hgrn_state_update(f32x4 (&S)[8], const char* smem, int w, int fr, int fq) {
  const float* dc = (const float*)(smem + H_DC); const f32x4 d4 = *(const f32x4*)(dc + 16 * w + fq * 4);
#pragma unroll
  for (int n = 0; n < 8; ++n) S[n] *= d4;
#pragma unroll
  for (int ks = 0; ks < 2; ++ks) { const bf16x8 a = lds_frag(smem + H_KHT, 16 * w + fr, P72, ks * 64 + fq * 16);
#pragma unroll
    for (int n = 0; n < 8; ++n) S[n] = __builtin_amdgcn_mfma_f32_16x16x32_bf16(a, lds_frag(smem + H_VTL, n * 16 + fr, P72, ks * 64 + fq * 16), S[n], 0, 0, 0); }
}

__device__ __forceinline__ int hgrn_block_row(int bl, int dir, int j) { return bl * SEQ + (dir ? 16 - j : j - 1) * 256; }

__device__ __forceinline__ void hgrn_local_item(const Params& p, int l, int it, char* smem, int tid) {
  const bool isc = it >= 480; const int ic = it - 480;
  const int j = isc ? 0 : 1 + it % 15, dir = isc ? (ic & 1) : (it / 15) & 1, h = isc ? (ic >> 1) & 3 : (it / 30) & 3, bl = isc ? (ic >> 3) : it / 120, chain = (bl * 4 + h) * 2 + dir;
  const bf16_t* z = (const bf16_t*)(p.ws + OFF_Z); const float* lbv = (const float*)(p.ws + OFF_LB) + ((size_t)dir * DEPTH + l) * 512;
  const int w = tid >> 6, lane = tid & 63, fr = lane & 15, fq = lane >> 4, rowbase = isc ? MLAT + bl * CTX : hgrn_block_row(bl, dir, j);
  f32x4 S[8];
#pragma unroll
  for (int n = 0; n < 8; ++n) S[n] = (f32x4){0.f, 0.f, 0.f, 0.f};
  float ld0 = 0.f, ld1 = 0.f;
  HRaw raw; hgrn_load<false>(raw, z, h, dir, rowbase, 0, tid);
  for (int c = 0; c < 4; ++c) {
    const float2 tt = hgrn_prep<false>(raw, lbv, h, smem, tid); ld0 += tt.x; ld1 += tt.y;
    if (c < 3) hgrn_load<false>(raw, z, h, dir, rowbase, c + 1, tid);
    __syncthreads();
    hgrn_state_update(S, smem, w, fr, fq);
    __syncthreads();
  }
  float* Lb = isc ? (float*)(p.ws + OFF_LCTX) + (size_t)chain * 16384 : (float*)(p.ws + OFF_MIX) + ((size_t)chain * NSC + j) * 16384;
#pragma unroll
  for (int n = 0; n < 8; ++n)
#pragma unroll
    for (int jj = 0; jj < 4; ++jj) Lb[(16 * w + fq * 4 + jj) * 128 + n * 16 + fr] = S[n][jj];
  if (tid < 64) { float* hd = isc ? (float*)(p.ws + OFF_HDC) + (size_t)chain * 128 : (float*)(p.ws + OFF_HD) + ((size_t)chain * NSC + j) * 128; hd[2 * tid] = __expf(ld0); hd[2 * tid + 1] = __expf(ld1); }
}

__device__ __forceinline__ void hgrn_out_item(const Params& p, int l, int g, int it, char* smem, int tid) {
  const bool isc = it >= 256; const int ic = it - 256;
  const int pb = isc ? 0 : 1 + (it & 15), h = isc ? (ic & 3) : (it >> 4) & 3, bl = isc ? (ic >> 2) : it >> 6, bglob = isc ? bl : g * GB + bl;
  const bf16_t* z = (const bf16_t*)(p.ws + OFF_Z); bf16_t* ya = (bf16_t*)(p.ws + OFF_Y);
  const int w = tid >> 6, lane = tid & 63, fr = lane & 15, fq = lane >> 4;
  const int rowbase = isc ? MLAT + bl * CTX : bl * SEQ + (pb - 1) * 256;
  const float* onw = p.onorm_w + l * 128;
  for (int dir = 0; dir < 2; ++dir) {
    const int chain = (bl * 4 + h) * 2 + dir, j = pb == 0 ? 0 : (dir ? 17 - pb : pb);
    const float* lbv = (const float*)(p.ws + OFF_LB) + ((size_t)dir * DEPTH + l) * 512;
    f32x4 S[8];
#pragma unroll
    for (int n = 0; n < 8; ++n) S[n] = (f32x4){0.f, 0.f, 0.f, 0.f};
    const int cchain = (bglob * 4 + h) * 2 + dir;
    { f32x4 Ln[8], dn;
#define HC_LOAD(i_) do { const int _i = (i_); const float* Lb = _i == 0 ? (const float*)(p.ws + OFF_LCTX) + (size_t)cchain * 16384 : (const float*)(p.ws + OFF_MIX) + ((size_t)chain * NSC + _i) * 16384; \
        dn = *(const f32x4*)((_i == 0 ? (const float*)(p.ws + OFF_HDC) + (size_t)cchain * 128 : (const float*)(p.ws + OFF_HD) + ((size_t)chain * NSC + _i) * 128) + 16 * w + fq * 4); \
        const float* _lp = Lb + (16 * w + fq * 4) * 128 + fr; asm volatile("" : "+v"(_lp)); \
        _Pragma("unroll") for (int n = 0; n < 8; ++n) _Pragma("unroll") for (int jj = 0; jj < 4; ++jj) Ln[n][jj] = _lp[jj * 128 + n * 16]; } while (0)
      if (j > 0) HC_LOAD(0);
      for (int i = 0; i < j; ++i) {
        f32x4 Lc[8]; const f32x4 dc4 = dn;
#pragma unroll
        for (int n = 0; n < 8; ++n) Lc[n] = Ln[n];
        if (i + 1 < j) HC_LOAD(i + 1);
#pragma unroll
        for (int n = 0; n < 8; ++n) S[n] = dc4 * S[n] + Lc[n];
      }
#undef HC_LOAD
    }
    HRaw raw; hgrn_load<false>(raw, z, h, dir, rowbase, 0, tid);
    for (int c = 0; c < 4; ++c) {
      { const int kp_ = tid & 63, part_ = tid >> 6;
#pragma unroll
        for (int e = 0; e < 8; ++e) { const int tau = c * 64 + part_ * 8 + e, row = rowbase + (dir ? 255 - tau : tau); raw.q[e] = *(const unsigned*)(z + (size_t)row * ZLD + h * 128 + 2 * kp_ + ZQ); } }
      hgrn_prep<true>(raw, lbv, h, smem, tid);
      u32x4 gq0 = {0, 0, 0, 0}, gq1 = {0, 0, 0, 0};
      if (dir == 1) {
        const bf16_t* gp = z + (size_t)(rowbase + 255 - (c * 64 + (tid >> 3))) * ZLD + ZG + h * 128 + (tid & 7) * 16;
        gq0 = *(const u32x4*)gp; gq1 = *(const u32x4*)(gp + 8);
      }
#pragma unroll
      for (int n = 0; n < 8; ++n) { u32x2 o; o.x = cvt_pk_bf16(S[n][0], S[n][1]); o.y = cvt_pk_bf16(S[n][2], S[n][3]); *(u32x2*)(smem + H_ST + (n * 16 + fr) * P136 + (16 * w + fq * 4) * 2) = o; }
      __syncthreads();
      {
        const int mt = w & 3;
        f32x4 pa[2] = {(f32x4){0.f, 0.f, 0.f, 0.f}, (f32x4){0.f, 0.f, 0.f, 0.f}};
#pragma unroll
        for (int ks = 0; ks < 4; ++ks) { const bf16x8 a = lds_frag(smem + H_QS, mt * 16 + fr, P136, ks * 64 + fq * 16);
#pragma unroll
          for (int e = 0; e < 2; ++e) pa[e] = __builtin_amdgcn_mfma_f32_16x16x32_bf16(a, lds_frag(smem + H_KS, ((w >> 2) * 2 + e) * 16 + fr, P136, ks * 64 + fq * 16), pa[e], 0, 0, 0); }
#pragma unroll
        for (int e = 0; e < 2; ++e) { const int sx = ((w >> 2) * 2 + e) * 16 + fr;
#pragma unroll
          for (int jj = 0; jj < 4; ++jj) { const int t = mt * 16 + fq * 4 + jj; *(bf16_t*)(smem + H_PL + t * P72 + sx * 2) = f2bf(sx <= t ? pa[e][jj] : 0.f); } }
      }
      __syncthreads();
      f32x4 O[4];
      { const int mt = w & 3, nh = w >> 2;
#pragma unroll
        for (int n = 0; n < 4; ++n) O[n] = (f32x4){0.f, 0.f, 0.f, 0.f};
#pragma unroll
        for (int ks = 0; ks < 4; ++ks) { const bf16x8 a = lds_frag(smem + H_QI, mt * 16 + fr, P136, ks * 64 + fq * 16);
#pragma unroll
          for (int n = 0; n < 4; ++n) O[n] = __builtin_amdgcn_mfma_f32_16x16x32_bf16(a, lds_frag(smem + H_ST, (nh * 4 + n) * 16 + fr, P136, ks * 64 + fq * 16), O[n], 0, 0, 0); }
#pragma unroll
        for (int ks = 0; ks < 2; ++ks) { const bf16x8 a = lds_frag(smem + H_PL, mt * 16 + fr, P72, ks * 64 + fq * 16);
#pragma unroll
          for (int n = 0; n < 4; ++n) O[n] = __builtin_amdgcn_mfma_f32_16x16x32_bf16(a, lds_frag(smem + H_VTL, (nh * 4 + n) * 16 + fr, P72, ks * 64 + fq * 16), O[n], 0, 0, 0); }
      }
      if (c < 3) { hgrn_state_update(S, smem, w, fr, fq); hgrn_load<false>(raw, z, h, dir, rowbase, c + 1, tid); }
      __syncthreads();
      { const int mt = w & 3, nh = w >> 2;
        float* Ot = (float*)(smem + H_ST);
        const int t0 = mt * 16 + fq * 4, v0 = nh * 64 + fr, tau0 = c * 64 + t0;
        bf16_t* yp0 = ya + (size_t)(rowbase + (dir ? 255 - tau0 : tau0)) * 512 + h * 128 + v0; asm volatile("" : "+v"(yp0));
        const int rstep = dir ? -512 : 512;
        if (dir == 0) {
#pragma unroll
          for (int n = 0; n < 4; ++n)
#pragma unroll
            for (int jj = 0; jj < 4; ++jj) yp0[jj * rstep + n * 16] = f2bf(O[n][jj]);
        } else {
          bf16_t yv[4][4];
#pragma unroll
          for (int n = 0; n < 4; ++n)
#pragma unroll
            for (int jj = 0; jj < 4; ++jj) yv[n][jj] = yp0[jj * rstep + n * 16];
#pragma unroll
          for (int n = 0; n < 4; ++n)
#pragma unroll
            for (int jj = 0; jj < 4; ++jj) Ot[(t0 + jj) * 132 + nh * 64 + n * 16 + fr] = O[n][jj] + bf2f(yv[n][jj]);
        }
      }
      __syncthreads();
      if (dir == 1) {
        const float* Ot = (const float*)(smem + H_ST);
        const int t = tid >> 3, vs = tid & 7, tau = c * 64 + t, row = rowbase + 255 - tau;
        float o[16]; float ss = 0.f;
#pragma unroll
        for (int i = 0; i < 16; ++i) { o[i] = Ot[t * 132 + vs * 16 + i]; ss += o[i] * o[i]; }
        ss += __shfl_xor(ss, 1); ss += __shfl_xor(ss, 2); ss += __shfl_xor(ss, 4);
        const float rstd = rsqrtf(ss * (1.f / 128.f) + 1e-6f);
        const u32x4 g0 = gq0, g1 = gq1;
        const unsigned gu[8] = {g0.x, g0.y, g0.z, g0.w, g1.x, g1.y, g1.z, g1.w}; unsigned ou[8];
#pragma unroll
        for (int i = 0; i < 8; ++i) ou[i] = cvt_pk_bf16(o[2 * i] * rstd * onw[vs * 16 + 2 * i] * bflo(gu[i]), o[2 * i + 1] * rstd * onw[vs * 16 + 2 * i + 1] * bfhi(gu[i]));
        bf16_t* yp = ya + (size_t)row * 512 + h * 128 + vs * 16;
        *(u32x4*)yp = (u32x4){ou[0], ou[1], ou[2], ou[3]}; *(u32x4*)(yp + 8) = (u32x4){ou[4], ou[5], ou[6], ou[7]};
        __syncthreads();
      }
    }
    __syncthreads();
  }
}

constexpr int NK = 832, KP = 144  , VP = 1680  , N_RPB = 122880;
__device__ __forceinline__ void natten_item(const Params& p, int l, int bl, int bg, int h, int rp, bool ctxq, char* smem, int tid) {
  const bf16_t* z = (const bf16_t*)(p.ws + OFF_Z);
  const int w = tid >> 6, lane = tid & 63, fr = lane & 15, fq = lane >> 4;
  const int r = 2 * rp + (w >> 2), jb = w & 3;
  const int r0 = min(max(r - 4, 0), 56), rlo = min(max(2 * rp - 4, 0), 56);
  const int cs = jb == 0 ? 0 : (jb == 1 ? 8 : (jb == 2 ? 24 : 32));
  { u32x4 tk[13];
#pragma unroll
    for (int i = 0; i < 13; ++i) { const int q = tid + i * 512, kr = q >> 3, pc = q & 7; int row;
      if (kr < 576) { const int br = min(rlo + (kr >> 6), 63); row = bl * SEQ + br * 64 + (kr & 63); } else row = MLAT + bg * CTX + (kr - 576);
      if (i >= 9 || !ctxq) tk[i] = *(const u32x4*)(z + (size_t)row * ZLD + ZNK + h * 64 + pc * 8); }
#pragma unroll
    for (int i = 0; i < 13; ++i) { const int q = tid + i * 512, kr = q >> 3, pc = q & 7;
      if (i >= 9 || !ctxq) *(u32x4*)(smem + kr * KP + pc * 16) = tk[i]; } }
  float* rpbs = (float*)(smem + N_RPB);
  for (int q = tid; q < 15 * 31; q += 512) rpbs[q] = p.rpb[((size_t)l * 8 + h) * 465 + q] * 1.4426950408889634f;
  const int qrow = ctxq ? (MLAT + bg * CTX + rp * 128 + w * 16 + fr) : (bl * SEQ + r * 64 + jb * 16 + fr);
  bf16x8 qf[2];
#pragma unroll
  for (int ks = 0; ks < 2; ++ks) qf[ks] = *(const bf16x8*)(z + (size_t)qrow * ZLD + ZNQ + h * 64 + ks * 32 + fq * 8);
  __syncthreads();
  f32x4 S[32];
#pragma unroll
  for (int ti = 0; ti < 32; ++ti) {
    S[ti] = (f32x4){0.f, 0.f, 0.f, 0.f};
    if (ti >= 16 || !ctxq) {
      const int base = ti < 16 ? ((r0 - rlo + (ti >> 1)) * 64 + cs + (ti & 1) * 16) : (576 + (ti - 16) * 16);
#pragma unroll
      for (int ks = 0; ks < 2; ++ks) S[ti] = __builtin_amdgcn_mfma_f32_16x16x32_bf16(lds_frag(smem, base + fr, KP, ks * 64 + fq * 16), qf[ks], S[ti], 0, 0, 0);
    }
    if ((ti & 3) == 3) __builtin_amdgcn_sched_barrier(0);
  }
  float mx = -1e30f;
  { const int c = jb * 16 + fr, cst = min(max(c - 8, 0), 48);
#pragma unroll
    for (int ti = 0; ti < 16; ++ti) {
#pragma unroll
      for (int jj = 0; jj < 4; ++jj) { const int kc = cs + (ti & 1) * 16 + fq * 4 + jj; const bool ok = !ctxq && kc >= cst && kc < cst + 16;
        const int rb = r0 + (ti >> 1) - r + 7, cb = min(max(kc - c + 15, 0), 30);
        S[ti][jj] = ok ? S[ti][jj] + rpbs[rb * 31 + cb] : -1e30f; mx = fmaxf(mx, S[ti][jj]); }
      if (ti & 1) __builtin_amdgcn_sched_barrier(0); }
#pragma unroll
    for (int ti = 16; ti < 32; ++ti)
#pragma unroll
      for (int jj = 0; jj < 4; ++jj) mx = fmaxf(mx, S[ti][jj]);
  }
  mx = fmaxf(mx, __shfl_xor(mx, 16)); mx = fmaxf(mx, __shfl_xor(mx, 32));
  float sum = 0.f;
#pragma unroll
  for (int ti = 0; ti < 32; ++ti)
#pragma unroll
    for (int jj = 0; jj < 4; ++jj) { const float e = __builtin_amdgcn_exp2f(S[ti][jj] - mx); S[ti][jj] = e; sum += e; }
  sum += __shfl_xor(sum, 16); sum += __shfl_xor(sum, 32);
  __syncthreads();
  { const bf16_t* vt = (const bf16_t*)(p.ws + OFF_VT) + ((size_t)(bl * 8 + h) * 64) * SEQ; const bf16_t* vtc = (const bf16_t*)(p.ws + OFF_VTC) + ((size_t)(bg * 8 + h) * 64) * CTX;
#pragma unroll
    for (int hb = 0; hb < 2; ++hb) { u32x4 tv[7];
#pragma unroll
      for (int i = 0; i < 7; ++i) { const int q = tid + (hb * 7 + i) * 512, d = q / 104, pc = q % 104;
        if (hb * 7 + i < 13) { if (pc >= 72) tv[i] = *(const u32x4*)(vtc + (size_t)d * CTX + (pc - 72) * 8);
          else if (!ctxq) tv[i] = *(const u32x4*)(vt + (size_t)d * SEQ + min(rlo * 64 + pc * 8, SEQ - 8)); } }
#pragma unroll
      for (int i = 0; i < 7; ++i) { const int q = tid + (hb * 7 + i) * 512, d = q / 104, pc = q % 104;
        if (hb * 7 + i < 13) { if (pc >= 72 || !ctxq) *(u32x4*)(smem + d * VP + pc * 16) = tv[i]; } } } }
  __syncthreads();
  f32x4 O[4];
#pragma unroll
  for (int dt = 0; dt < 4; ++dt) O[dt] = (f32x4){0.f, 0.f, 0.f, 0.f};
#pragma unroll
  for (int u = 0; u < 16; ++u) {
    if (u >= 8 || !ctxq) {
      const int tA = 2 * u, tB = 2 * u + 1;
      const int bA = tA < 16 ? ((r0 - rlo + (tA >> 1)) * 64 + cs + (tA & 1) * 16) : (576 + (tA - 16) * 16);
      const int bB = tB < 16 ? ((r0 - rlo + (tB >> 1)) * 64 + cs + (tB & 1) * 16) : (576 + (tB - 16) * 16);
      union { bf16x8 v; unsigned u4[4]; } pf;
      pf.u4[0] = cvt_pk_bf16(S[tA][0], S[tA][1]); pf.u4[1] = cvt_pk_bf16(S[tA][2], S[tA][3]); pf.u4[2] = cvt_pk_bf16(S[tB][0], S[tB][1]); pf.u4[3] = cvt_pk_bf16(S[tB][2], S[tB][3]);
#pragma unroll
      for (int dt = 0; dt < 4; ++dt) {
        union { bf16x8 v; u32x2 h2[2]; } vf;
        vf.h2[0] = *(const u32x2*)(smem + (dt * 16 + fr) * VP + (bA + fq * 4) * 2);
        vf.h2[1] = *(const u32x2*)(smem + (dt * 16 + fr) * VP + (bB + fq * 4) * 2);
        O[dt] = __builtin_amdgcn_mfma_f32_16x16x32_bf16(vf.v, pf.v, O[dt], 0, 0, 0);
      }
    }
    __builtin_amdgcn_sched_barrier(0);
  }
  const float inv = 1.f / sum;
  bf16_t* yb = (bf16_t*)(p.ws + OFF_Y) + (size_t)MG * 512 + (size_t)qrow * 512 + h * 64;
#pragma unroll
  for (int dt = 0; dt < 4; ++dt) { u32x2 o; o.x = cvt_pk_bf16(O[dt][0] * inv, O[dt][1] * inv); o.y = cvt_pk_bf16(O[dt][2] * inv, O[dt][3] * inv); *(u32x2*)(yb + dt * 16 + fq * 4) = o; }
  __syncthreads();
}

#define QUEUE_LOOP(n_items_, ...) do { \
    unsigned* _qc = (unsigned*)(p.ws + OFF_BAR + 3456 * 4) + ph; volatile unsigned* _slot = (volatile unsigned*)(smem + LDS_TOP - 8); \
    int it = bid_(); \
    while (it < (n_items_)) { asm volatile("" : "+v"(tid)); __VA_ARGS__ \
      __syncthreads(); if (tid == 0) *_slot = gridDim.x + __hip_atomic_fetch_add(_qc, 1u, __ATOMIC_RELAXED, __HIP_MEMORY_SCOPE_AGENT); __syncthreads(); it = __builtin_amdgcn_readfirstlane((int)*_slot); } } while (0)

__device__ __forceinline__ void phase_mix_a(const Params& p, int l, int g, bool with_ctx, int ph, char* smem) {
  int tid = threadIdx.x; asm volatile("" : "+v"(tid));
  const int n_ha = 480 + (with_ctx ? 64 : 0), n_tb = (with_ctx ? MG : MLAT) / 64;
  QUEUE_LOOP(n_ha + n_tb,
    if (it < n_ha) hgrn_local_item(p, l, it, smem, tid); else tokblock_item(p, l, it - n_ha, smem, tid, true); );
  (void)g;
}
__device__ __forceinline__ void phase_mix_b(const Params& p, int l, int g, bool with_ctx, bool up_ctx, int ph, char* smem) {
  int tid = threadIdx.x; asm volatile("" : "+v"(tid));
  const int n_hc = 256 + (with_ctx ? 32 : 0), n_up = 0, n_na = GB * 8 * 32, n_nc = with_ctx ? NB * 8 * 2 : 0;
  QUEUE_LOOP(n_hc + n_up + n_na + n_nc,
    if (it < n_hc) hgrn_out_item(p, l, g, it, smem, tid);
    else if (it < n_hc + n_up + n_na) { const int q = it - n_hc - n_up; natten_item(p, l, q >> 8, g * GB + (q >> 8), (q >> 5) & 7, q & 31, false, smem, tid); }
    else { const int q = it - n_hc - n_up - n_na; natten_item(p, l, 0, q >> 4, (q >> 1) & 7, q & 1, true, smem, tid); } );
}

constexpr int NPH = 1 + DEPTH * NG * 9;

__global__ __launch_bounds__(512) void mega(Params p_unused) {
  extern __shared__ __attribute__((aligned(16))) char smem[];
  cg::grid_group grid = cg::this_grid();
  LAS unsigned char* lds = (LAS unsigned char*)smem;
  const __attribute__((address_space(4))) Params* kp = (const __attribute__((address_space(4))) Params*)__builtin_amdgcn_kernarg_segment_ptr();
  const int ph_lo = kp->ph_lo, ph_hi = kp->ph_hi;
  volatile LAS unsigned* xbst = (volatile LAS unsigned*)(lds + LDS_BYTES - 16);
  if (threadIdx.x == 0) { xbst[0] = 0u; xbst[1] = 0u; }
  __syncthreads();
  (void)xcd_barrier_post((unsigned*)(kp->ws + OFF_BAR), xbst);
#define MK_XB XcdBarrier xb; xb.bar = (unsigned*)(p.ws + OFF_BAR); xb.x = xb_xcc_id(); xb.st = (volatile LAS unsigned*)(lds + LDS_BYTES - 16)
  for (int ph = ph_lo; ph < ph_hi; ++ph) {
    const __attribute__((address_space(4))) Params* q4 = kp; asm volatile("" : "+s"(q4));
    const Params& p = *(const Params*)q4;
    if (ph == 0) { phase_prologue(p, smem); }
    else {
      const int q = ph - 1, k = q % 9, lg = q / 9, g = lg % NG, l = lg / NG;
      const bool need_ctx = l < DEPTH - 1, cx = need_ctx && g == 1;
      const int bid = bid_(), nb = gridDim.x;
      switch (k) {
        case 0: if (g == 0) { phase_wconv(p, l, smem); phase_norm(p, l, 0, 0, 0, MG, bid, nb); }
                else if (cx) { if (bid < 32) phase_merge(p, MLAT / BM, MCTX / BM, 0, lds); else phase_norm(p, l, 1, 0, 0, MLAT, bid - 32, nb - 32); }
                else phase_norm(p, l, 1, 0, 0, MLAT, bid, nb);
                break;
        case 1: phase_gemm1(p, g == 0 ? MG / BM : MLAT / BM, g == 0 && !need_ctx, lds);
                if (cx) phase_gemm_resid(p, l, g, p.ws + OFF_MIX, D, p.ws + OFF_WO, 2, MLAT / BM, MCTX / BM, 128, lds);
                break;
        case 2: phase_mix_a(p, l, g, g == 0, ph, smem); if (cx) phase_norm(p, l, g, 1, MLAT, MG, bid, nb); break;
        case 3: if (cx) phase_up(p, (bf16_t*)(p.ws + OFF_UC) - (size_t)MLAT * DFF, Sched<1>{MCTX / BM, DFF / BM, MLAT / BM, 128}, lds);
                phase_mix_b(p, l, g, g == 0 && need_ctx, cx, ph, smem); break;
        case 4: phase_merge(p, 0, MLAT / BM, 0, lds); if (cx) phase_down_ctx(p, l, lds); break;
        case 5: if (cx) { int t_ = threadIdx.x; asm volatile("" : "+v"(t_)); phase_down_ctx_combine(p, l, bid, t_); }
                phase_gemm_resid(p, l, g, p.ws + OFF_MIX, D, p.ws + OFF_WO, 2, 0, MLAT / BM, 0, lds); break;
        case 6: phase_norm(p, l, g, 1, 0, MLAT, bid, nb); break;
        case 7: phase_up(p, (bf16_t*)(p.ws + OFF_Z), Sched<1>{MLAT / BM, DFF / BM, 0, 0}, lds); break;
        case 8: phase_gemm_resid(p, l, g, p.ws + OFF_Z, DFF, p.ws + OFF_W2, 5, 0, MLAT / BM, 0, lds); break;
      }
    }
    if (ph + 1 < ph_hi) { if (ph == 0) grid.sync(); else { MK_XB; xcd_barrier(xb); } }
  }
}


extern "C" void kernel_launch(void* const* d_in, const int* in_sizes, int n_in, void* d_out, int out_size, void* d_ws, size_t ws_size, hipStream_t stream) {
  static int grid_blocks = 0;
  if (!grid_blocks) {
    int dev = 0, cus = 0, per_cu = 0;
    hipGetDevice(&dev);
    hipDeviceGetAttribute(&cus, hipDeviceAttributeMultiprocessorCount, dev);
    hipFuncSetAttribute((const void*)mega, hipFuncAttributeMaxDynamicSharedMemorySize, LDS_BYTES);
    hipOccupancyMaxActiveBlocksPerMultiprocessor(&per_cu, mega, 512, LDS_BYTES);
    if (per_cu < 1) per_cu = 1;
    grid_blocks = cus;
    if (ws_size < WS_NEED) fprintf(stderr, "workspace too small: %zu < %zu\n", ws_size, (size_t)WS_NEED);
  }
  Params p{};
  const float** f = (const float**)&p;
  for (int i = 0; i < 21; ++i) f[i] = (const float*)d_in[i];
  p.out = (float*)d_out; p.ws = (char*)d_ws; p.ph_lo = 0; p.ph_hi = NPH;
  hipMemsetAsync((char*)d_ws + OFF_BAR, 0, XCD_BAR_BYTES, stream);
  void* args[] = {&p};
  hipError_t e = hipLaunchCooperativeKernel((void*)mega, dim3(grid_blocks), dim3(512), args, LDS_BYTES, stream);
  if (e != hipSuccess) fprintf(stderr, "cooperative launch failed: %s (grid %d)\n", hipGetErrorString(e), grid_blocks);
}
```
